# Optimizing an MI355X kernel written in HIP

```python
import math
import jax, jax.numpy as jnp
from jax import lax
import numpy as np

D_MODEL = 1024
BATCH = 8
SEQ = 8192
DEPTH = 1

HEAD_DIM = 64
N_ATTN_HEADS = 8
ATTN_WIDTH = N_ATTN_HEADS * HEAD_DIM
N_SSM_HEADS = 24
SSM_WIDTH = N_SSM_HEADS * HEAD_DIM
MIX_WIDTH = ATTN_WIDTH + SSM_WIDTH
SSM_GROUPS = 2
SSM_STATE = 128
CONV_WIDTH = 4
CONV_DIM = SSM_WIDTH + 2 * SSM_GROUPS * SSM_STATE
SSD_CHUNK = 128
DILATED_PATTERNS = ((128, 1), (512, 4), (2048, 16))
IN_PROJ = 3 * ATTN_WIDTH + SSM_WIDTH + CONV_DIM + N_SSM_HEADS
D_FF = -(-8 * D_MODEL // (3 * 256)) * 256
PLE_DIM = 256
EPS = 1e-6

kernel_name = "hymba_ssd_dilated_swa_block"


def rms_norm(x, gain):
    xf = x.astype(jnp.float32)
    y = xf * lax.rsqrt(jnp.mean(xf * xf, axis=-1, keepdims=True) + EPS)
    return (y * gain.astype(jnp.float32)).astype(x.dtype)


def dilated_window_attention(q, k, v, window, dilation):
    b, s, h, dh = q.shape
    n = window // dilation
    span = n * dilation
    s_pad = -(-s // span) * span
    nb = s_pad // span

    def blocks(t):
        t = jnp.pad(t, ((0, 0), (0, s_pad - s), (0, 0), (0, 0)))
        return t.reshape(b, nb, n, dilation, h, dh)

    def with_prev(t):
        prev = jnp.pad(t[:, :-1], ((0, 0), (1, 0), (0, 0), (0, 0), (0, 0), (0, 0)))
        return jnp.concatenate([prev, t], axis=2)

    qb = blocks(q)
    kc = with_prev(blocks(k))
    vc = with_prev(blocks(v))
    scores = jnp.einsum('bnidhe,bnjdhe->bndhij', qb, kc,
                        preferred_element_type=jnp.float32)
    qi = jnp.arange(n)[:, None]
    kj = jnp.arange(2 * n)[None, :]
    dist = qi + n - kj
    band = (dist >= 0) & (dist <= n)
    first = (jnp.arange(nb) == 0)[:, None, None] & (kj < n)[None]
    mask = band[None] & ~first
    scores = jnp.where(mask[:, None, None], scores, -jnp.inf)
    m = jnp.max(scores, axis=-1, keepdims=True)
    e = jnp.exp(scores - m)
    den = jnp.sum(e, axis=-1, keepdims=True)
    out = jnp.einsum('bndhij,bnjdhe->bndhie', e, vc.astype(jnp.float32)) / den
    lse = (m + jnp.log(den))[..., 0]
    out = out.transpose(0, 1, 4, 2, 3, 5).reshape(b, s_pad, h, dh)[:, :s]
    lse = lse.transpose(0, 1, 4, 2, 3).reshape(b, s_pad, h)[:, :s]
    return out, lse


def mixture_of_dilations(q, k, v):
    outs, lses = [], []
    for window, dilation in DILATED_PATTERNS:
        o, l = dilated_window_attention(q, k, v, window, dilation)
        outs.append(o)
        lses.append(l)
    wts = jax.nn.softmax(jnp.stack(lses, axis=0), axis=0)
    return jnp.einsum('pbsh,pbshe->bshe', wts, jnp.stack(outs, axis=0))


def causal_depthwise_conv(u, w, bias):
    c = u.shape[-1]
    out = lax.conv_general_dilated(u, w[:, None, :].astype(u.dtype), window_strides=(1,),
                                   padding=[(w.shape[0] - 1, 0)],
                                   dimension_numbers=('NWC', 'WIO', 'NWC'),
                                   feature_group_count=c)
    return out + bias.astype(u.dtype)


def ssd_chunked(x, dt, a, bm, cm):
    b, s, h, pdim = x.shape
    g, n = bm.shape[2], bm.shape[3]
    hg = h // g
    q = SSD_CHUNK
    s_pad = -(-s // q) * q
    nc = s_pad // q

    def pad(t):
        return jnp.pad(t, [(0, 0), (0, s_pad - s)] + [(0, 0)] * (t.ndim - 2))

    xc = pad(x * dt[..., None]).reshape(b, nc, q, g, hg, pdim)
    da = pad(dt * a).reshape(b, nc, q, g, hg)
    bc = pad(bm).reshape(b, nc, q, g, n)
    cc = pad(cm).reshape(b, nc, q, g, n)
    acs = jnp.cumsum(da, axis=2)

    seg = acs[:, :, :, None] - acs[:, :, None, :]
    causal = jnp.tril(jnp.ones((q, q), dtype=bool))
    decay = jnp.exp(jnp.where(causal[:, :, None, None], seg, -jnp.inf))
    cb = jnp.einsum('bclgn,bcsgn->bclsg', cc, bc)
    y_diag = jnp.einsum('bclsgh,bcsghp->bclghp', cb[..., None] * decay, xc)

    decay_to_end = jnp.exp(acs[:, :, -1:] - acs)
    states = jnp.einsum('bcsgn,bcsgh,bcsghp->bcghpn', bc, decay_to_end, xc)
    chunk_decay = jnp.exp(acs[:, :, -1])

    def step(carry, inp):
        st, dec = inp
        return carry * dec[..., None, None] + st, carry

    init = jnp.zeros((b, g, hg, pdim, n), jnp.float32)
    _, prev_states = lax.scan(step, init, (jnp.moveaxis(states, 1, 0),
                                           jnp.moveaxis(chunk_decay, 1, 0)))
    prev_states = jnp.moveaxis(prev_states, 0, 1)
    y_off = jnp.einsum('bclgn,bcghpn,bclgh->bclghp', cc, prev_states, jnp.exp(acs))
    return (y_diag + y_off).reshape(b, s_pad, h, pdim)[:, :s]


def gated_group_rms_norm(y, z, gain):
    b, s, w = y.shape
    u = (y.astype(jnp.float32) * jax.nn.silu(z.astype(jnp.float32))).reshape(b, s, SSM_GROUPS, w // SSM_GROUPS)
    u = u * lax.rsqrt(jnp.mean(u * u, axis=-1, keepdims=True) + EPS)
    return u.reshape(b, s, w) * gain.astype(jnp.float32)


def setup_inputs(seed: int = 0) -> dict:
    key = jax.random.key(seed)
    ks = jax.random.split(key, 24)
    L = DEPTH
    f32 = jnp.float32

    def dense(k, shape, fan_in):
        return jax.random.normal(k, shape, f32) * fan_in ** -0.5

    def gain(k, shape):
        return 1.0 + 0.02 * jax.random.normal(k, shape, f32)

    dt0 = jnp.exp(jax.random.uniform(ks[10], (L, N_SSM_HEADS), f32,
                                     minval=math.log(1e-3), maxval=math.log(1e-1)))
    return {
        "x": jax.random.normal(ks[0], (BATCH, SEQ, D_MODEL), f32),
        "p": jax.random.normal(ks[1], (DEPTH, BATCH, SEQ, PLE_DIM), f32),
        "mix_norm": gain(ks[2], (L, D_MODEL)),
        "w_in": dense(ks[3], (L, D_MODEL, IN_PROJ), D_MODEL),
        "q_norm": gain(ks[4], (L, HEAD_DIM)),
        "k_norm": gain(ks[5], (L, HEAD_DIM)),
        "conv_w": dense(ks[6], (L, CONV_WIDTH, CONV_DIM), CONV_WIDTH),
        "conv_b": 0.02 * jax.random.normal(ks[7], (L, CONV_DIM), f32),
        "dt_bias": dt0 + jnp.log(-jnp.expm1(-dt0)),
        "a_log": jnp.log(jax.random.uniform(ks[8], (L, N_SSM_HEADS), f32, minval=1.0, maxval=16.0)),
        "d_skip": gain(ks[9], (L, N_SSM_HEADS)),
        "ssm_norm": gain(ks[11], (L, SSM_WIDTH)),
        "w_out": dense(ks[12], (L, MIX_WIDTH, D_MODEL), MIX_WIDTH),
        "ffn_norm": gain(ks[13], (L, D_MODEL)),
        "w_ffn_gate": dense(ks[14], (L, D_MODEL, D_FF), D_MODEL),
        "w_ffn_up": dense(ks[15], (L, D_MODEL, D_FF), D_MODEL),
        "w_ffn_down": dense(ks[16], (L, D_FF, D_MODEL), D_FF),
        "ple_gate_norm": gain(ks[17], (L, D_MODEL)),
        "w_ple_gate": dense(ks[18], (L, D_MODEL, D_MODEL), D_MODEL),
        "b_ple_gate": 0.02 * jax.random.normal(ks[19], (L, D_MODEL), f32),
        "w_ple": dense(ks[20], (L, PLE_DIM, D_MODEL), PLE_DIM),
        "ple_norm": gain(ks[21], (L, D_MODEL)),
    }


def reference(x, p, mix_norm, w_in, q_norm, k_norm, conv_w, conv_b, dt_bias, a_log, d_skip,
              ssm_norm, w_out, ffn_norm, w_ffn_gate, w_ffn_up, w_ffn_down, ple_gate_norm,
              w_ple_gate, b_ple_gate, w_ple, ple_norm):
    b, s, _ = x.shape
    splits = [ATTN_WIDTH, 2 * ATTN_WIDTH, 3 * ATTN_WIDTH,
              3 * ATTN_WIDTH + SSM_WIDTH, 3 * ATTN_WIDTH + SSM_WIDTH + CONV_DIM]
    for i in range(DEPTH):
        h = rms_norm(x, mix_norm[i])
        proj = h @ w_in[i]
        q, k, v, z, xbc, dt_raw = jnp.split(proj, splits, axis=-1)

        q = rms_norm(q.reshape(b, s, N_ATTN_HEADS, HEAD_DIM), q_norm[i]) * (HEAD_DIM ** -0.5)
        k = rms_norm(k.reshape(b, s, N_ATTN_HEADS, HEAD_DIM), k_norm[i])
        v = v.reshape(b, s, N_ATTN_HEADS, HEAD_DIM)
        attn = mixture_of_dilations(q, k, v).reshape(b, s, ATTN_WIDTH)

        xbc = jax.nn.silu(causal_depthwise_conv(xbc, conv_w[i], conv_b[i]))
        xs, bm, cm = jnp.split(xbc, [SSM_WIDTH, SSM_WIDTH + SSM_GROUPS * SSM_STATE], axis=-1)
        xs = xs.reshape(b, s, N_SSM_HEADS, HEAD_DIM).astype(jnp.float32)
        dt = jax.nn.softplus(dt_raw.astype(jnp.float32) + dt_bias[i].astype(jnp.float32))
        a = -jnp.exp(a_log[i].astype(jnp.float32))
        y = ssd_chunked(xs, dt, a,
                        bm.reshape(b, s, SSM_GROUPS, SSM_STATE).astype(jnp.float32),
                        cm.reshape(b, s, SSM_GROUPS, SSM_STATE).astype(jnp.float32))
        y = y + d_skip[i].astype(jnp.float32)[:, None] * xs
        y = gated_group_rms_norm(y.reshape(b, s, SSM_WIDTH), z, ssm_norm[i])

        mixed = jnp.concatenate([attn.astype(x.dtype), y.astype(x.dtype)], axis=-1)
        x = x + mixed @ w_out[i]

        h = rms_norm(x, ffn_norm[i])
        x = x + (jax.nn.silu(h @ w_ffn_gate[i]) * (h @ w_ffn_up[i])) @ w_ffn_down[i]

        gate = jax.nn.sigmoid(rms_norm(x, ple_gate_norm[i]) @ w_ple_gate[i] + b_ple_gate[i])
        e = rms_norm(p[i] @ w_ple[i], ple_norm[i])
        x = x + gate * e
    return x
```

```cpp
#include <hip/hip_runtime.h>
#include <hip/hip_cooperative_groups.h>
#include <cstdio>
#include <cstdint>
namespace cg = cooperative_groups;
namespace pg8 {
#define PG8_LAS __attribute__((address_space(3)))
typedef unsigned short bf16_t;
typedef short bf16x8 __attribute__((ext_vector_type(8)));
typedef float f32x4 __attribute__((ext_vector_type(4)));
typedef unsigned u32x4 __attribute__((ext_vector_type(4)));
constexpr int BM = 256, BK = 64, HALF = 128, HTB = HALF * BK * 2  , STAGE_BYTES = 8 * HTB, NXCD = 8, WGM = 8;

__host__ __device__ __forceinline__ int lds_byte(int r, int c) { const int st = (r >> 4) * 2 + (c >> 5), rr = r & 15, cc = c & 31, ob = rr * 64 + cc * 2; return st * 1024 + (ob ^ (((ob >> 9) & 1) << 5)); }
__host__ __device__ __forceinline__ void stage_rc(int b, int& R, int& C) { const int st = b / 1024, sb = b % 1024, swz = sb ^ (((sb >> 9) & 1) << 5); R = (st >> 1) * 16 + swz / 64; C = (st & 1) * 32 + (swz % 64) / 2; }
__host__ __device__ __forceinline__ int perm32(int rho) { const int n = rho >> 4, i = rho & 15; return 8 * (i >> 2) + 4 * n + (i & 3); }

struct Unit { int pm, pn; };
struct Gemm { const bf16_t* A; const bf16_t* Bt; int M, N, K; };

struct StaticOrder {
    int nM, nN, nwg, G, c;
    __host__ __device__ void init(int M, int N, int G_, int c_) { nM = M / BM; nN = N / BM; nwg = nM * nN; G = G_; c = c_; }
    __host__ __device__ bool next(int i, Unit& u) const {
        const long L = (long)i * G + c; if (L >= nwg) return false;
        int wgid = (int)L; { const int q = nwg / NXCD, r = nwg % NXCD, xcd = wgid % NXCD, off = wgid / NXCD; wgid = (xcd < r ? xcd * (q + 1) : r * (q + 1) + (xcd - r) * q) + off; }
        const int nig = WGM * nN, gid = wgid / nig, fm = gid * WGM, gsz = (nM - fm) < WGM ? (nM - fm) : WGM;
        u.pm = fm + ((wgid % nig) % gsz); u.pn = (wgid % nig) / gsz; return true;
    }
    __device__ __forceinline__ void a_ready(const Unit&) const {}
    __device__ __forceinline__ void done(const Unit&) const {}
};
__device__ __forceinline__ unsigned cvt_pk_bf16(float lo, float hi) { unsigned r; asm volatile("v_cvt_pk_bf16_f32 %0, %1, %2" : "=v"(r) : "v"(lo), "v"(hi)); return r; }

template <class Epi, class Sched, bool ALIGN_EPI = false, bool SP2 = false>
__device__ __forceinline__ void gemm_phase(PG8_LAS unsigned char* lds, const Gemm g, const Sched& S, const Epi& E, const int wid) {
    int lane; asm volatile("v_mbcnt_lo_u32_b32 %0, -1, 0\n\tv_mbcnt_hi_u32_b32 %0, -1, %0" : "=v"(lane));
    const int tid = wid * 64 + lane, wr = wid >> 2, wc = wid & 3, fr = lane & 15, fq = lane >> 4;
    const int K = g.K, nt = K / BK;
    unsigned voffA[2], voffB[2];
#pragma unroll
    for (int i = 0; i < 2; ++i) { int R, C; stage_rc(tid * 16 + i * 8192, R, C); const int Rb = Epi::PERM ? ((R & ~31) + perm32(R & 31)) : R;
        voffA[i] = (unsigned)(R * K + C) * 2u; voffB[i] = (unsigned)(Rb * K + C) * 2u; }
    const size_t kstep = (size_t)(BK * 2);
    const size_t hstep = (size_t)HALF * K * 2;
    const size_t tstep = 2 * hstep;
    const unsigned ldsw = (unsigned)wid * 1024u;
    const int aoff = lds_byte(wr * 64 + fr, fq * 8), boff = lds_byte(wc * 32 + fr, fq * 8);
#define PG8_SA(b, h) (((b) * 2 + (h)) * HTB)
#define PG8_SB(b, h) ((4 + (b) * 2 + (h)) * HTB)
#define PG8_STAGE(bufoff, gbase, voff) do { _Pragma("unroll") for (int _i = 0; _i < 2; ++_i) \
        __builtin_amdgcn_global_load_lds((const unsigned*)((const char*)(gbase) + (voff)[_i]), (PG8_LAS unsigned*)(lds + (bufoff) + ldsw + _i * 8192), 16, 0, 0); } while (0)
#define PG8_LDA(dst, b, h) do { _Pragma("unroll") for (int m = 0; m < 4; ++m) _Pragma("unroll") for (int k = 0; k < 2; ++k) dst[m][k] = *(const PG8_LAS bf16x8*)(lds + PG8_SA(b, h) + aoff + m * 2048 + k * 1024); } while (0)
#define PG8_LDB(dst, b, h) do { _Pragma("unroll") for (int n = 0; n < 2; ++n) _Pragma("unroll") for (int k = 0; k < 2; ++k) dst[n][k] = *(const PG8_LAS bf16x8*)(lds + PG8_SB(b, h) + boff + n * 2048 + k * 1024); } while (0)
#define PG8_MMA(ai, bj, At, Bt) do { __builtin_amdgcn_s_setprio(1); _Pragma("unroll") for (int m = 0; m < 4; ++m) _Pragma("unroll") for (int n = 0; n < 2; ++n) _Pragma("unroll") for (int k = 0; k < 2; ++k) \
        acc[ai][bj][m][n] = __builtin_amdgcn_mfma_f32_16x16x32_bf16(Bt[n][k], At[m][k], acc[ai][bj][m][n], 0, 0, 0); __builtin_amdgcn_s_setprio(0); } while (0)
#define PG8_WAIT_V(n) asm volatile("s_waitcnt vmcnt(" #n ")" ::: "memory")
#define PG8_WAIT_L(n) asm volatile("s_waitcnt lgkmcnt(" #n ")" ::: "memory")
#define PG8_BAR __builtin_amdgcn_s_barrier()
#define PG8_SCHED __builtin_amdgcn_sched_barrier(0)
    Unit cur, nxt; int ui = 0;
    if (!S.next(0, cur)) return;
    f32x4 acc[2][2][4][2];
#pragma unroll
    for (int a = 0; a < 2; ++a)
#pragma unroll
        for (int b = 0; b < 2; ++b)
#pragma unroll
            for (int m = 0; m < 4; ++m)
#pragma unroll
                for (int n = 0; n < 2; ++n) acc[a][b][m][n] = (f32x4){0.f, 0.f, 0.f, 0.f};
    bf16x8 At[4][2], B0[2][2], B1[2][2];
    const char* cA = (const char*)g.A + (size_t)cur.pm * tstep; const char* cB = (const char*)g.Bt + (size_t)cur.pn * tstep;
    S.a_ready(cur);
    if constexpr (SP2) {
        PG8_STAGE(PG8_SB(0, 0), cB, voffB); PG8_STAGE(PG8_SB(0, 1), cB + hstep, voffB); PG8_STAGE(PG8_SA(0, 0), cA, voffA); PG8_STAGE(PG8_SA(0, 1), cA + hstep, voffA);
        if (wr == 1) PG8_BAR;
        PG8_WAIT_V(2); PG8_BAR;
        PG8_STAGE(PG8_SB(1, 0), cB + kstep, voffB); PG8_STAGE(PG8_SA(1, 0), cA + kstep, voffA); PG8_STAGE(PG8_SB(1, 1), cB + hstep + kstep, voffB);
        PG8_WAIT_V(6); PG8_BAR;
    } else {
        PG8_STAGE(PG8_SB(0, 0), cB, voffB); PG8_STAGE(PG8_SA(0, 0), cA, voffA); PG8_STAGE(PG8_SB(0, 1), cB + hstep, voffB); PG8_STAGE(PG8_SA(0, 1), cA + hstep, voffA);
        if (wr == 1) PG8_BAR;
        PG8_WAIT_V(4); PG8_BAR;
        PG8_STAGE(PG8_SB(1, 0), cB + kstep, voffB); PG8_STAGE(PG8_SA(1, 0), cA + kstep, voffA); PG8_STAGE(PG8_SB(1, 1), cB + hstep + kstep, voffB);
        PG8_WAIT_V(6); PG8_BAR;
    }
    for (;;) {
        const bool has_next = S.next(ui + 1, nxt);
        const char* nA = has_next ? (const char*)g.A + (size_t)nxt.pm * tstep : cA; const char* nB = has_next ? (const char*)g.Bt + (size_t)nxt.pn * tstep : cB;
        for (int t = 0; t < nt; t += 2) {
            if constexpr (Epi::HAS_HOOK) E.hook(t, acc, cur, wr, fr);
            const bool last = (t == nt - 2);
            const char* a1 = cA + (size_t)(t + 1) * kstep;
            const char* a2 = last ? nA : cA + (size_t)(t + 2) * kstep; const char* b2 = last ? nB : cB + (size_t)(t + 2) * kstep;
            const char* a3 = a2 + kstep; const char* b3 = b2 + kstep;
            if (last && has_next) S.a_ready(nxt);
            if constexpr (SP2) {
            PG8_LDB(B0, 0, 0); PG8_LDB(B1, 0, 1); PG8_SCHED; PG8_LDA(At, 0, 0); PG8_STAGE(PG8_SA(1, 1), a1 + hstep, voffA);
            PG8_WAIT_V(8); PG8_WAIT_L(0); PG8_BAR; PG8_MMA(0, 0, At, B0); PG8_MMA(0, 1, At, B1); PG8_BAR; PG8_SCHED;
            PG8_LDA(At, 0, 1); PG8_STAGE(PG8_SB(0, 0), b2, voffB); PG8_STAGE(PG8_SB(0, 1), b2 + hstep, voffB); PG8_STAGE(PG8_SA(0, 0), a2, voffA);
            PG8_WAIT_V(8); PG8_WAIT_L(0); PG8_BAR; PG8_MMA(1, 0, At, B0); PG8_MMA(1, 1, At, B1); PG8_BAR; PG8_SCHED;
            PG8_LDB(B0, 1, 0); PG8_LDB(B1, 1, 1); PG8_SCHED; PG8_LDA(At, 1, 0); PG8_STAGE(PG8_SA(0, 1), a2 + hstep, voffA);
            PG8_WAIT_V(8); PG8_WAIT_L(0); PG8_BAR; PG8_MMA(0, 0, At, B0); PG8_MMA(0, 1, At, B1); PG8_BAR; PG8_SCHED;
            PG8_LDA(At, 1, 1); PG8_STAGE(PG8_SB(1, 0), b3, voffB); PG8_STAGE(PG8_SB(1, 1), b3 + hstep, voffB); PG8_STAGE(PG8_SA(1, 0), a3, voffA);
            PG8_WAIT_V(8); PG8_WAIT_L(0); PG8_BAR; PG8_MMA(1, 0, At, B0); PG8_MMA(1, 1, At, B1); PG8_BAR; PG8_SCHED;
            } else {
            PG8_LDB(B0, 0, 0); PG8_SCHED; PG8_LDA(At, 0, 0); PG8_STAGE(PG8_SA(1, 1), a1 + hstep, voffA);
            PG8_WAIT_L(8); PG8_BAR; PG8_WAIT_L(0); PG8_MMA(0, 0, At, B0); PG8_BAR; PG8_SCHED;
            PG8_LDB(B1, 0, 1); PG8_STAGE(PG8_SB(0, 0), b2, voffB);
            PG8_BAR; PG8_WAIT_L(0); PG8_MMA(0, 1, At, B1); PG8_BAR;
            PG8_LDA(At, 0, 1); PG8_STAGE(PG8_SA(0, 0), a2, voffA);
            PG8_BAR; PG8_WAIT_L(0); PG8_MMA(1, 0, At, B0); PG8_BAR; PG8_SCHED;
            PG8_STAGE(PG8_SB(0, 1), b2 + hstep, voffB);
            PG8_WAIT_V(6); PG8_BAR; PG8_MMA(1, 1, At, B1); PG8_BAR;
            PG8_LDB(B0, 1, 0); PG8_SCHED; PG8_LDA(At, 1, 0); PG8_STAGE(PG8_SA(0, 1), a2 + hstep, voffA);
            PG8_WAIT_L(8); PG8_BAR; PG8_WAIT_L(0); PG8_MMA(0, 0, At, B0); PG8_BAR; PG8_SCHED;
            PG8_LDB(B1, 1, 1); PG8_STAGE(PG8_SB(1, 0), b3, voffB);
            PG8_BAR; PG8_WAIT_L(0); PG8_MMA(0, 1, At, B1); PG8_BAR;
            PG8_LDA(At, 1, 1); PG8_STAGE(PG8_SA(1, 0), a3, voffA);
            PG8_BAR; PG8_WAIT_L(0); PG8_MMA(1, 0, At, B0); PG8_BAR; PG8_SCHED;
            PG8_STAGE(PG8_SB(1, 1), b3 + hstep, voffB);
            PG8_WAIT_V(6); PG8_BAR; PG8_MMA(1, 1, At, B1); PG8_BAR;
            }
        }
        if constexpr (ALIGN_EPI) { if (wr == 0) PG8_BAR; }
        if constexpr (!Epi::AFTER_DRAIN) { E(acc, cur, wr, wc, fr, fq); S.done(cur); }
        if (!has_next) break;
#pragma unroll
        for (int a = 0; a < 2; ++a)
#pragma unroll
            for (int b = 0; b < 2; ++b)
#pragma unroll
                for (int m = 0; m < 4; ++m)
#pragma unroll
                    for (int n = 0; n < 2; ++n) acc[a][b][m][n] = (f32x4){0.f, 0.f, 0.f, 0.f};
        cur = nxt; cA = nA; cB = nB; ++ui;
        if constexpr (ALIGN_EPI) { if (wr == 1) PG8_BAR; }
    }
    PG8_WAIT_V(0);
    if constexpr (!ALIGN_EPI) { if (wr == 0) PG8_BAR; }
    PG8_BAR;
    if constexpr (Epi::AFTER_DRAIN) { E.fused(acc, cur, wr, wc, fr, fq, lds, wid, lane); S.done(cur); }
#undef PG8_SA
#undef PG8_SB
#undef PG8_STAGE
#undef PG8_LDA
#undef PG8_LDB
#undef PG8_MMA
#undef PG8_WAIT_V
#undef PG8_WAIT_L
#undef PG8_BAR
#undef PG8_SCHED
}
}

#ifndef MK_N_LAUNCHES
#define MK_N_LAUNCHES 1
#endif
constexpr int M = 65536, SEQ = 8192, D = 1024, NPROJ = 5144, NP = 5376, AW = 512, SW = 1536, CD = 2048, FF = 2816, PD = 256, NH = 24, MIXW = 2048;
constexpr int NPH = 10;
constexpr float EPS = 1e-6f;
constexpr float LOG2E = 1.4426950408889634f;
constexpr size_t MiB = 1u << 20;
constexpr size_t WS_SSQ1 = 0, WS_SSQ2 = 256 * 1024, WS_SSQT = 512 * 1024;
constexpr size_t WS_HALO = 1 * MiB;
constexpr size_t WS_DT = 4 * MiB, WS_ACS = 10 * MiB;
constexpr size_t WS_WIN = 16 * MiB, WS_WOUT = 27 * MiB, WS_WGU = 31 * MiB, WS_WDN = 42 * MiB, WS_WPG = 48 * MiB, WS_WPLE = 50 * MiB;
constexpr size_t WS_PB = 52 * MiB;
constexpr size_t WS_Q = 84 * MiB, WS_K = 148 * MiB, WS_V = 212 * MiB;
constexpr size_t WS_Z = 276 * MiB;
constexpr size_t WS_XBC = 468 * MiB;
constexpr size_t WS_MIX = 724 * MiB;
constexpr size_t WS_RS = 980 * MiB;
constexpr size_t WS_END = 981 * MiB;
constexpr size_t WS_XB = WS_Q;
constexpr size_t WS_HMID = WS_Z;
constexpr size_t WS_T = WS_MIX;
static_assert(WS_HMID + (size_t)M * FF * 2 <= WS_MIX, "hmid overlay");

#define LAS __attribute__((address_space(3)))
typedef unsigned short bf16;
using pg8::bf16x8; using pg8::f32x4; using pg8::u32x4; using pg8::Unit;
typedef unsigned u32x2 __attribute__((ext_vector_type(2)));

typedef float f32x2_t __attribute__((ext_vector_type(2)));
typedef __bf16 bf16x2_t __attribute__((ext_vector_type(2)));
__device__ __forceinline__ unsigned pk(float lo, float hi) { f32x2_t v = {lo, hi}; bf16x2_t b = __builtin_convertvector(v, bf16x2_t); return __builtin_bit_cast(unsigned, b); }
__device__ __forceinline__ bf16x8 pack8(f32x4 a, f32x4 b) { u32x4 w; w.x = pk(a[0], a[1]); w.y = pk(a[2], a[3]); w.z = pk(b[0], b[1]); w.w = pk(b[2], b[3]); return __builtin_bit_cast(bf16x8, w); }
__device__ __forceinline__ u32x4 pack8u(f32x4 a, f32x4 b) { u32x4 w; w.x = pk(a[0], a[1]); w.y = pk(a[2], a[3]); w.z = pk(b[0], b[1]); w.w = pk(b[2], b[3]); return w; }
__device__ __forceinline__ float bflo(unsigned u) { return __uint_as_float(u << 16); }
__device__ __forceinline__ float bfhi(unsigned u) { return __uint_as_float(u & 0xffff0000u); }
__device__ __forceinline__ float ex2(float x) { return __builtin_amdgcn_exp2f(x); }
__device__ __forceinline__ float fexp(float x) { return __builtin_amdgcn_exp2f(x * LOG2E); }
__device__ __forceinline__ float sigm(float x) { return __builtin_amdgcn_rcpf(1.f + fexp(-x)); }
__device__ __forceinline__ f32x4 mfma16(bf16x8 a, bf16x8 b, f32x4 c) { return __builtin_amdgcn_mfma_f32_16x16x32_bf16(a, b, c, 0, 0, 0); }
__device__ __forceinline__ float wave_sum(float v) {
#pragma unroll
    for (int o = 1; o < 64; o <<= 1) v += __shfl_xor(v, o);
    return v;
}
typedef unsigned u32x2s __attribute__((ext_vector_type(2)));
__device__ __forceinline__ float red_max_g4(float x) {
    const unsigned u = __float_as_uint(x); const u32x2s r = __builtin_amdgcn_permlane16_swap(u, u, false, false);
    const float m = fmaxf(__uint_as_float(r.x), __uint_as_float(r.y));
    const unsigned v = __float_as_uint(m); const u32x2s s = __builtin_amdgcn_permlane32_swap(v, v, false, false);
    return fmaxf(__uint_as_float(s.x), __uint_as_float(s.y));
}
__device__ __forceinline__ float red_sum_g4(float x) {
    const unsigned u = __float_as_uint(x); const u32x2s r = __builtin_amdgcn_permlane16_swap(u, u, false, false);
    const float m = __uint_as_float(r.x) + __uint_as_float(r.y);
    const unsigned v = __float_as_uint(m); const u32x2s s = __builtin_amdgcn_permlane32_swap(v, v, false, false);
    return __uint_as_float(s.x) + __uint_as_float(s.y);
}
__device__ __forceinline__ int kkmap(int m, int hf) { return 8 * (m >> 2) + 4 * hf + (m & 3); }

struct EpiInProj {
    static constexpr bool PERM = true, AFTER_DRAIN = false, HAS_HOOK = false;
    unsigned char* ws; const float *qn, *kn, *dtb;
    __device__ __forceinline__ void operator()(const f32x4 (&acc)[2][2][4][2], const Unit& u, int wr, int wc, int fr, int fq) const {
        const int pn = u.pn; const int row0 = u.pm * 256 + wr * 64 + fr;
        if (pn < 4) {
            const bool isq = pn < 2; const float* gn = isq ? qn : kn; bf16* dst = (bf16*)(ws + (isq ? WS_Q : WS_K));
            const float sc = isq ? 0.125f * LOG2E : 1.f;
            const int hd = 4 * (pn & 1) + wc;
            f32x4 gv[2][2];
#pragma unroll
            for (int bj = 0; bj < 2; ++bj)
#pragma unroll
                for (int n = 0; n < 2; ++n) gv[bj][n] = *(const f32x4*)(gn + 32 * bj + 8 * fq + 4 * n) * sc;
#pragma unroll
            for (int ai = 0; ai < 2; ++ai)
#pragma unroll
                for (int m = 0; m < 4; ++m) {
                    float ss = 0.f;
#pragma unroll
                    for (int bj = 0; bj < 2; ++bj)
#pragma unroll
                        for (int n = 0; n < 2; ++n) { const f32x4 x = acc[ai][bj][m][n]; ss += (x[0] * x[0] + x[1] * x[1]) + (x[2] * x[2] + x[3] * x[3]); }
                    ss = red_sum_g4(ss);
                    const float rs = rsqrtf(ss * (1.f / 64.f) + EPS);
                    bf16* rowp = dst + (size_t)(row0 + ai * 128 + m * 16) * AW + hd * 64 + 8 * fq;
#pragma unroll
                    for (int bj = 0; bj < 2; ++bj) *(u32x4*)(rowp + 32 * bj) = pack8u(acc[ai][bj][m][0] * rs * gv[bj][0], acc[ai][bj][m][1] * rs * gv[bj][1]);
                }
        } else if (pn < 20) {
            int ldc, colt; size_t woff;
            if (pn < 6) { woff = WS_V; ldc = AW; colt = (pn - 4) * 256; } else if (pn < 12) { woff = WS_Z; ldc = SW; colt = (pn - 6) * 256; } else { woff = WS_XBC; ldc = CD; colt = (pn - 12) * 256; }
            bf16* dst = (bf16*)(ws + woff);
            const int col0 = colt + wc * 32 + 8 * fq;
#pragma unroll
            for (int ai = 0; ai < 2; ++ai)
#pragma unroll
                for (int m = 0; m < 4; ++m) {
                    bf16* rowp = dst + (size_t)(row0 + ai * 128 + m * 16) * ldc + col0;
#pragma unroll
                    for (int bj = 0; bj < 2; ++bj) *(u32x4*)(rowp + bj * 128) = pack8u(acc[ai][bj][m][0], acc[ai][bj][m][1]);
                }
            if (pn >= 12 && wr == 1 && fr >= 13) {
                bf16* hp = (bf16*)(ws + WS_HALO) + ((size_t)u.pm * 3 + (fr - 13)) * CD + col0;
#pragma unroll
                for (int bj = 0; bj < 2; ++bj) *(u32x4*)(hp + bj * 128) = pack8u(acc[1][bj][3][0], acc[1][bj][3][1]);
            }
        } else {
            if (wc == 0 && fq < 3) {
                f32x4 bv[2];
#pragma unroll
                for (int n = 0; n < 2; ++n) bv[n] = *(const f32x4*)(dtb + 8 * fq + 4 * n);
#pragma unroll
                for (int ai = 0; ai < 2; ++ai)
#pragma unroll
                    for (int m = 0; m < 4; ++m) {
                        float* rowp = (float*)(ws + WS_DT) + (size_t)(row0 + ai * 128 + m * 16) * NH + 8 * fq;
#pragma unroll
                        for (int n = 0; n < 2; ++n) { f32x4 x = acc[ai][0][m][n] + bv[n], o;
#pragma unroll
                            for (int e = 0; e < 4; ++e) o[e] = fmaxf(x[e], 0.f) + log1pf(fexp(-fabsf(x[e])));
                            *(f32x4*)(rowp + 4 * n) = o; }
                    }
            }
        }
    }
};

template <bool HOOK> struct EpiResNorm {
    static constexpr bool PERM = true, AFTER_DRAIN = false, HAS_HOOK = HOOK;
    const float* base; float* out; bf16* xb; const float* gain; float* ssq; const float* rsg;
    __device__ __forceinline__ void hook(int t, f32x4 (&acc)[2][2][4][2], const Unit& u, int wr, int fr) const {
        if (t != 12 && t != 24) return;
        const int row0 = u.pm * 256 + wr * 64 + fr;
#pragma unroll
        for (int ai = 0; ai < 2; ++ai)
#pragma unroll
            for (int m = 0; m < 4; ++m) {
                const float r0 = rsg[2 * (row0 + ai * 128 + m * 16)], r1 = rsg[2 * (row0 + ai * 128 + m * 16) + 1];
                const float sc = (t == 12) ? r0 / r1 : r1;
#pragma unroll
                for (int bj = 0; bj < 2; ++bj)
#pragma unroll
                    for (int n = 0; n < 2; ++n) acc[ai][bj][m][n] *= sc;
            }
    }
    __device__ __forceinline__ void operator()(const f32x4 (&acc)[2][2][4][2], const Unit& u, int wr, int wc, int fr, int fq) const {
        const int row0 = u.pm * 256 + wr * 64 + fr, col0 = u.pn * 256 + wc * 32 + 8 * fq;
        f32x4 gv[2][2];
#pragma unroll
        for (int bj = 0; bj < 2; ++bj)
#pragma unroll
            for (int n = 0; n < 2; ++n) gv[bj][n] = *(const f32x4*)(gain + col0 + bj * 128 + 4 * n);
        f32x4 xin[2][2][2];
#pragma unroll
        for (int bj = 0; bj < 2; ++bj)
#pragma unroll
            for (int n = 0; n < 2; ++n) xin[0][bj][n] = *(const f32x4*)(base + (size_t)row0 * D + col0 + bj * 128 + 4 * n);
#pragma unroll
        for (int i = 0; i < 8; ++i) {
            const int ai = i >> 2, m = i & 3, r = row0 + ai * 128 + m * 16;
            if (i + 1 < 8) { const int rn = row0 + ((i + 1) >> 2) * 128 + ((i + 1) & 3) * 16;
#pragma unroll
                for (int bj = 0; bj < 2; ++bj)
#pragma unroll
                    for (int n = 0; n < 2; ++n) xin[(i + 1) & 1][bj][n] = *(const f32x4*)(base + (size_t)rn * D + col0 + bj * 128 + 4 * n); }
            float ss = 0.f;
#pragma unroll
            for (int bj = 0; bj < 2; ++bj) {
                const size_t off = (size_t)r * D + col0 + bj * 128;
                const f32x4 v0 = xin[i & 1][bj][0] + acc[ai][bj][m][0], v1 = xin[i & 1][bj][1] + acc[ai][bj][m][1];
                *(f32x4*)(out + off) = v0; *(f32x4*)(out + off + 4) = v1;
                ss += (v0[0] * v0[0] + v0[1] * v0[1]) + (v0[2] * v0[2] + v0[3] * v0[3]) + (v1[0] * v1[0] + v1[1] * v1[1]) + (v1[2] * v1[2] + v1[3] * v1[3]);
                *(u32x4*)(xb + off) = pack8u(v0 * gv[bj][0], v1 * gv[bj][1]);
            }
            ss = red_sum_g4(ss);
            if (fq == 0) unsafeAtomicAdd(ssq + r, ss);
        }
    }
};

struct EpiSwiGLU {
    static constexpr bool PERM = true, AFTER_DRAIN = false, HAS_HOOK = false;
    const float* ssq; bf16* h;
    __device__ __forceinline__ void operator()(const f32x4 (&acc)[2][2][4][2], const Unit& u, int wr, int wc, int fr, int fq) const {
        const int row0 = u.pm * 256 + wr * 64 + fr, col0 = u.pn * 128 + wc * 32 + 8 * fq;
        float sq8[2][4];
#pragma unroll
        for (int ai = 0; ai < 2; ++ai)
#pragma unroll
            for (int m = 0; m < 4; ++m) sq8[ai][m] = ssq[row0 + ai * 128 + m * 16];
#pragma unroll
        for (int ai = 0; ai < 2; ++ai)
#pragma unroll
            for (int m = 0; m < 4; ++m) {
                const int r = row0 + ai * 128 + m * 16;
                const float rs = rsqrtf(sq8[ai][m] * (1.f / D) + EPS);
                f32x4 hv[2];
#pragma unroll
                for (int n = 0; n < 2; ++n) { const f32x4 g = acc[ai][0][m][n] * rs, uu = acc[ai][1][m][n] * rs;
#pragma unroll
                    for (int e = 0; e < 4; ++e) hv[n][e] = g[e] * sigm(g[e]) * uu[e]; }
                *(u32x4*)(h + (size_t)r * FF + col0) = pack8u(hv[0], hv[1]);
            }
    }
};

struct EpiPle {
    static constexpr bool PERM = true, AFTER_DRAIN = false, HAS_HOOK = false;
    bf16* t; float* ssq;
    __device__ __forceinline__ void operator()(const f32x4 (&acc)[2][2][4][2], const Unit& u, int wr, int wc, int fr, int fq) const {
        const int row0 = u.pm * 256 + wr * 64 + fr, col0 = u.pn * 256 + wc * 32 + 8 * fq;
#pragma unroll
        for (int ai = 0; ai < 2; ++ai)
#pragma unroll
            for (int m = 0; m < 4; ++m) {
                const int r = row0 + ai * 128 + m * 16; float ss = 0.f;
#pragma unroll
                for (int bj = 0; bj < 2; ++bj) {
                    const f32x4 v0 = acc[ai][bj][m][0], v1 = acc[ai][bj][m][1];
                    ss += (v0[0] * v0[0] + v0[1] * v0[1]) + (v0[2] * v0[2] + v0[3] * v0[3]) + (v1[0] * v1[0] + v1[1] * v1[1]) + (v1[2] * v1[2] + v1[3] * v1[3]);
                    *(u32x4*)(t + (size_t)r * D + col0 + bj * 128) = pack8u(v0, v1);
                }
                ss = red_sum_g4(ss);
                if (fq == 0) unsafeAtomicAdd(ssq + r, ss);
            }
    }
};

struct EpiFinal {
    static constexpr bool PERM = true, AFTER_DRAIN = false, HAS_HOOK = false;
    float* out; const bf16* t; const float *ssq2, *ssqt, *bias, *png;
    __device__ __forceinline__ void operator()(const f32x4 (&acc)[2][2][4][2], const Unit& u, int wr, int wc, int fr, int fq) const {
        const int row0 = u.pm * 256 + wr * 64 + fr, col0 = u.pn * 256 + wc * 32 + 8 * fq;
        f32x4 bv[2][2], gv[2][2];
#pragma unroll
        for (int bj = 0; bj < 2; ++bj)
#pragma unroll
            for (int n = 0; n < 2; ++n) { bv[bj][n] = *(const f32x4*)(bias + col0 + bj * 128 + 4 * n); gv[bj][n] = *(const f32x4*)(png + col0 + bj * 128 + 4 * n); }
        f32x4 xin[2][2][2]; u32x4 tin[2][2]; float q2[2], qt[2];
        q2[0] = ssq2[row0]; qt[0] = ssqt[row0];
#pragma unroll
        for (int bj = 0; bj < 2; ++bj) { const size_t off = (size_t)row0 * D + col0 + bj * 128; tin[0][bj] = *(const u32x4*)(t + off); xin[0][bj][0] = *(const f32x4*)(out + off); xin[0][bj][1] = *(const f32x4*)(out + off + 4); }
#pragma unroll
        for (int i = 0; i < 8; ++i) {
            const int ai = i >> 2, m = i & 3, r = row0 + ai * 128 + m * 16;
            if (i + 1 < 8) { const int rn = row0 + ((i + 1) >> 2) * 128 + ((i + 1) & 3) * 16; q2[(i + 1) & 1] = ssq2[rn]; qt[(i + 1) & 1] = ssqt[rn];
#pragma unroll
                for (int bj = 0; bj < 2; ++bj) { const size_t off = (size_t)rn * D + col0 + bj * 128; tin[(i + 1) & 1][bj] = *(const u32x4*)(t + off); xin[(i + 1) & 1][bj][0] = *(const f32x4*)(out + off); xin[(i + 1) & 1][bj][1] = *(const f32x4*)(out + off + 4); } }
            const float rs2 = rsqrtf(q2[i & 1] * (1.f / D) + EPS), rst = rsqrtf(qt[i & 1] * (1.f / D) + EPS);
#pragma unroll
            for (int bj = 0; bj < 2; ++bj) {
                const size_t off = (size_t)r * D + col0 + bj * 128;
                const u32x4 tw = tin[i & 1][bj];
                f32x4 tv[2] = {{bflo(tw.x), bfhi(tw.x), bflo(tw.y), bfhi(tw.y)}, {bflo(tw.z), bfhi(tw.z), bflo(tw.w), bfhi(tw.w)}};
#pragma unroll
                for (int n = 0; n < 2; ++n) {
                    const f32x4 x2 = xin[i & 1][bj][n]; const f32x4 a = acc[ai][bj][m][n] * rs2 + bv[bj][n]; f32x4 o;
#pragma unroll
                    for (int e = 0; e < 4; ++e) o[e] = x2[e] + sigm(a[e]) * (tv[n][e] * rst * gv[bj][n][e]);
                    *(f32x4*)(out + off + 4 * n) = o;
                }
            }
        }
    }
};

__device__ __forceinline__ void make_isel(int lane, bf16x8 (&isel)[2]) {
    const int c = lane & 15, g4 = lane >> 4;
#pragma unroll
    for (int o = 0; o < 2; ++o)
#pragma unroll
        for (int j = 0; j < 8; ++j) isel[o][j] = (8 * g4 + j == 16 * o + c) ? (short)0x3F80 : (short)0;
}
struct Args { const float* in[22]; float* out; unsigned char* ws; int ph_lo, ph_hi; };

__device__ __forceinline__ void transpose_item(const float* colp, int ld, int K, bf16* WT, int k0, int n0, LAS float* scr, int lane, const float* kgain = nullptr) {
#pragma unroll 8
    for (int i = 0; i < 32; ++i) { const int kk = 2 * i + (lane >> 5); const float gsc = kgain ? kgain[k0 + kk] : 1.f; scr[kk * 33 + (lane & 31)] = colp ? colp[(ptrdiff_t)(k0 + kk) * ld] * gsc : 0.f; }
    asm volatile("s_waitcnt lgkmcnt(0)" ::: "memory");
    const int c = lane & 7;
#pragma unroll
    for (int j = 0; j < 4; ++j) { const int n = (lane >> 3) + 8 * j; const LAS float* s = scr + (8 * c) * 33 + n;
        u32x4 o; o.x = pk(s[0 * 33], s[1 * 33]); o.y = pk(s[2 * 33], s[3 * 33]); o.z = pk(s[4 * 33], s[5 * 33]); o.w = pk(s[6 * 33], s[7 * 33]);
        *(u32x4*)(WT + (size_t)(n0 + n) * K + k0 + 8 * c) = o; }
    asm volatile("s_waitcnt lgkmcnt(0)" ::: "memory");
}

__device__ __forceinline__ void p0_prologue(const Args& a, LAS unsigned char* lds, int tid, int lane, int wave, int G) {
    unsigned char* ws = a.ws;
    LAS float* scr = (LAS float*)(lds + wave * 16384);
    const int gw = blockIdx.x * 8 + wave, NGW = G * 8;
    constexpr int I_IN = (D / 64) * (NP / 32), I_OUT = (MIXW / 64) * (D / 32), I_GU = (D / 64) * (2 * FF / 32), I_DN = (FF / 64) * (D / 32), I_PG = (D / 64) * (D / 32), I_PLE = (PD / 64) * (D / 32);
    constexpr int NITEMS = I_IN + I_OUT + I_GU + I_DN + I_PG + I_PLE;
    for (int it = gw; it < NITEMS; it += NGW) {
        int r = it;
        if (r < I_IN) {
            const int nblk = NP / 32, kb = r / nblk, nb = r % nblk, np = nb * 32 + (lane & 31); int col;
            if (np < 1024) { const int seg = np >> 9, p = np & 511, tile = p >> 8, pos = p & 255, bj = pos >> 7, wc = (pos & 127) >> 5, j = pos & 31; col = seg * 512 + (4 * tile + wc) * 64 + 32 * bj + j; }
            else col = np;
            transpose_item(col < NPROJ ? a.in[3] + col : nullptr, NPROJ, D, (bf16*)(ws + WS_WIN), 64 * kb, 32 * nb, scr, lane); continue; }
        r -= I_IN;
        if (r < I_OUT) {
            const int nblk = D / 32, kb = r / nblk, nb = r % nblk, k0 = 64 * kb; const int srck0 = k0 < SW ? AW + k0 : k0 - SW;
            transpose_item(a.in[12] + (ptrdiff_t)(srck0 - k0) * D + nb * 32 + (lane & 31), D, MIXW, (bf16*)(ws + WS_WOUT), k0, 32 * nb, scr, lane, k0 < SW ? a.in[11] : nullptr); continue; }
        r -= I_OUT;
        if (r < I_GU) {
            const int nblk = 2 * FF / 32, kb = r / nblk, nb = r % nblk, np = nb * 32 + (lane & 31);
            const int pn = np >> 8, pos = np & 255, bj = pos >> 7, wc = (pos & 127) >> 5, j = pos & 31, ff = 128 * pn + 32 * wc + j;
            transpose_item((bj ? a.in[15] : a.in[14]) + ff, FF, D, (bf16*)(ws + WS_WGU), 64 * kb, 32 * nb, scr, lane); continue; }
        r -= I_GU;
        if (r < I_DN) { const int nblk = D / 32, kb = r / nblk, nb = r % nblk; transpose_item(a.in[16] + nb * 32 + (lane & 31), D, FF, (bf16*)(ws + WS_WDN), 64 * kb, 32 * nb, scr, lane); continue; }
        r -= I_DN;
        if (r < I_PG) { const int nblk = D / 32, kb = r / nblk, nb = r % nblk; transpose_item(a.in[18] + nb * 32 + (lane & 31), D, D, (bf16*)(ws + WS_WPG), 64 * kb, 32 * nb, scr, lane); continue; }
        r -= I_PG;
        { const int nblk = D / 32, kb = r / nblk, nb = r % nblk; transpose_item(a.in[20] + nb * 32 + (lane & 31), D, PD, (bf16*)(ws + WS_WPLE), 64 * kb, 32 * nb, scr, lane); }
    }
    {
        bf16* h0 = (bf16*)a.out; const float* x = a.in[0]; const float* gn = a.in[2];
        f32x4 g4v[4];
#pragma unroll
        for (int j = 0; j < 4; ++j) g4v[j] = *(const f32x4*)(gn + 4 * (64 * j + lane));
        for (int m0 = gw; m0 < M; m0 += 4 * NGW) {
            f32x4 v[4][4];
#pragma unroll
            for (int rr = 0; rr < 4; ++rr) { const int m = m0 + rr * NGW; if (m < M) { const f32x4* xr = (const f32x4*)(x + (size_t)m * D) + lane;
#pragma unroll
                for (int j = 0; j < 4; ++j) v[rr][j] = xr[64 * j]; } }
#pragma unroll
            for (int rr = 0; rr < 4; ++rr) { const int m = m0 + rr * NGW; if (m < M) {
                float sacc = 0.f;
#pragma unroll
                for (int j = 0; j < 4; ++j) sacc += (v[rr][j][0] * v[rr][j][0] + v[rr][j][1] * v[rr][j][1]) + (v[rr][j][2] * v[rr][j][2] + v[rr][j][3] * v[rr][j][3]);
                const float rs = rsqrtf(wave_sum(sacc) * (1.f / D) + EPS);
                u32x2* o8 = (u32x2*)(h0 + (size_t)m * D) + lane;
#pragma unroll
                for (int j = 0; j < 4; ++j) { const f32x4 w = v[rr][j] * rs * g4v[j]; u32x2 o; o.x = pk(w[0], w[1]); o.y = pk(w[2], w[3]); o8[64 * j] = o; } } }
        }
    }
    {
        const int gt = blockIdx.x * 512 + tid, NT = G * 512;
        const f32x4* p4 = (const f32x4*)a.in[1]; u32x4* pb = (u32x4*)(ws + WS_PB);
        for (int i0 = gt; i0 < M * PD / 8; i0 += 4 * NT) {
            f32x4 v[4][2];
#pragma unroll
            for (int j = 0; j < 4; ++j) { const int i = i0 + j * NT; if (i < M * PD / 8) { v[j][0] = p4[2 * i]; v[j][1] = p4[2 * i + 1]; } }
#pragma unroll
            for (int j = 0; j < 4; ++j) { const int i = i0 + j * NT; if (i < M * PD / 8) pb[i] = pack8u(v[j][0], v[j][1]); }
        }
        float* sq = (float*)(ws + WS_SSQ1);
        for (int i = gt; i < 3 * M; i += NT) sq[i] = 0.f;
    }
}

__device__ __forceinline__ void conv_unit(const Args& a, int pm, int cs, int tid) {
    bf16* xbc = (bf16*)(a.ws + WS_XBC); const bf16* halo = (const bf16*)(a.ws + WS_HALO);
    const int cg8 = tid & 31, rseg = tid >> 5, col = cs * 256 + cg8 * 8, r0 = pm * 256 + rseg * 16;
    u32x4 raw[19];
#pragma unroll
    for (int i = 0; i < 3; ++i) {
        if (rseg > 0) raw[i] = *(const u32x4*)(xbc + (size_t)(r0 - 3 + i) * CD + col);
        else if ((pm & 31) != 0) raw[i] = *(const u32x4*)(halo + ((size_t)(pm - 1) * 3 + i) * CD + col);
        else raw[i] = (u32x4){0u, 0u, 0u, 0u};
    }
#pragma unroll
    for (int i = 0; i < 16; ++i) raw[3 + i] = *(const u32x4*)(xbc + (size_t)(r0 + i) * CD + col);
    f32x4 w[4][2], bv[2];
#pragma unroll
    for (int k = 0; k < 4; ++k) { w[k][0] = *(const f32x4*)(a.in[6] + k * CD + col); w[k][1] = *(const f32x4*)(a.in[6] + k * CD + col + 4); }
    bv[0] = *(const f32x4*)(a.in[7] + col); bv[1] = *(const f32x4*)(a.in[7] + col + 4);
    asm volatile("s_waitcnt vmcnt(0)" ::: "memory");
    __syncthreads();
#pragma unroll
    for (int i = 0; i < 16; ++i) {
        f32x4 acc0 = bv[0], acc1 = bv[1];
#pragma unroll
        for (int k = 0; k < 4; ++k) { const u32x4 u = raw[i + k];
            acc0 += w[k][0] * (f32x4){bflo(u.x), bfhi(u.x), bflo(u.y), bfhi(u.y)}; acc1 += w[k][1] * (f32x4){bflo(u.z), bfhi(u.z), bflo(u.w), bfhi(u.w)}; }
#pragma unroll
        for (int e = 0; e < 4; ++e) { acc0[e] = acc0[e] * sigm(acc0[e]); acc1[e] = acc1[e] * sigm(acc1[e]); }
        *(u32x4*)(xbc + (size_t)(r0 + i) * CD + col) = pack8u(acc0, acc1);
    }
}

__device__ __forceinline__ void acs_task(const Args& a, int task, int lane) {
    const float* dt = (const float*)(a.ws + WS_DT); float* acs = (float*)(a.ws + WS_ACS);
    const int cidx = task / NH, h = task % NH; const float av = -fexp(a.in[9][h]);
    const size_t r0 = (size_t)cidx * 128 + 2 * lane;
    const float v = dt[r0 * NH + h] * av, w = dt[(r0 + 1) * NH + h] * av;
    float s = v + w;
#pragma unroll
    for (int o = 1; o < 64; o <<= 1) { const float t = __shfl_up(s, o); if (lane >= o) s += t; }
    const float ex = s - (v + w);
    acs[r0 * NH + h] = ex + v; acs[(r0 + 1) * NH + h] = ex + v + w;
}

template <int DIL>
__device__ __forceinline__ void attn_pattern(const bf16* Kp, const bf16* Vp, size_t browbase, int hd, int T0, int r, int c, int g4,
                                             const bf16x8 (&qf)[2], const bf16x8 (&isel)[2], f32x4 (&o)[4], float& m_run, float& l_run) {
    constexpr int G = 16 / DIL, NT = DIL == 1 ? 12 : (DIL == 4 ? 6 : 5);
    const int rm = r % DIL, S0 = (T0 + r - rm) / DIL, s_lo = (S0 - 128) & ~7;
    const int sq = S0 + G * c;
    const int wlo = sq - 128 > 0 ? sq - 128 : 0; const unsigned wspan = (unsigned)(sq - wlo); const int kbase = s_lo + 8 * g4 - wlo;
    bf16x8 kb_[3][2][2], vb_[3][2][2];
    auto load_tile = [&](int tt, bf16x8 (&kk_)[2][2], bf16x8 (&vv_)[2][2]) {
#pragma unroll
        for (int hf = 0; hf < 2; ++hf) {
            int s = s_lo + 32 * tt + kkmap(c, hf); s = s < 0 ? 0 : s;
            int tok = s * DIL + rm; tok = tok > SEQ - 1 ? SEQ - 1 : tok;
            const size_t off = (browbase + tok) * AW + hd * 64 + 8 * g4;
#pragma unroll
            for (int ks = 0; ks < 2; ++ks) { kk_[hf][ks] = *(const bf16x8*)(Kp + off + 32 * ks); vv_[hf][ks] = *(const bf16x8*)(Vp + off + 32 * ks); }
        }
    };
    load_tile(0, kb_[0], vb_[0]); load_tile(1, kb_[1], vb_[1]);
#pragma unroll
    for (int tt = 0; tt < NT; ++tt) {
        if (tt + 2 < NT) load_tile(tt + 2, kb_[(tt + 2) % 3], vb_[(tt + 2) % 3]);
        const bf16x8 (&kf)[2][2] = kb_[tt % 3]; const bf16x8 (&vf)[2][2] = vb_[tt % 3];
        f32x4 sacc[2];
#pragma unroll
        for (int hf = 0; hf < 2; ++hf) { sacc[hf] = mfma16(kf[hf][0], qf[0], (f32x4){0.f, 0.f, 0.f, 0.f}); sacc[hf] = mfma16(kf[hf][1], qf[1], sacc[hf]); }
        float tmax = -INFINITY;
#pragma unroll
        for (int hf = 0; hf < 2; ++hf)
#pragma unroll
            for (int e = 0; e < 4; ++e) { const bool ok = (unsigned)(kbase + 32 * tt + 4 * hf + e) <= wspan;
                sacc[hf][e] = ok ? sacc[hf][e] : -INFINITY; tmax = fmaxf(tmax, sacc[hf][e]); }
        tmax = red_max_g4(tmax);
        if (__builtin_amdgcn_ballot_w64(tmax > m_run + 8.f) != 0ull) {
            const float m_new = fmaxf(m_run, tmax), m_u = (m_new == -INFINITY) ? 0.f : m_new, alpha = ex2(m_run - m_u);
            l_run *= alpha; m_run = m_new;
#pragma unroll
            for (int dvt = 0; dvt < 4; ++dvt) o[dvt] = o[dvt] * alpha;
        }
        const float m_use = (m_run == -INFINITY) ? 0.f : m_run;
        float ps = 0.f;
#pragma unroll
        for (int hf = 0; hf < 2; ++hf)
#pragma unroll
            for (int e = 0; e < 4; ++e) { sacc[hf][e] = ex2(sacc[hf][e] - m_use); ps += sacc[hf][e]; }
        l_run += ps;
        const bf16x8 pf = pack8(sacc[0], sacc[1]);
#pragma unroll
        for (int dvt = 0; dvt < 4; ++dvt) {
            const f32x4 z4 = {0.f, 0.f, 0.f, 0.f};
            const f32x4 t0 = mfma16(vf[0][dvt >> 1], isel[dvt & 1], z4), t1 = mfma16(vf[1][dvt >> 1], isel[dvt & 1], z4);
            o[dvt] = mfma16(pack8(t0, t1), pf, o[dvt]);
        }
    }
}

__device__ __forceinline__ void attn_tile(const bf16x8 (&kf)[2][2], const bf16x8 (&vt)[4], const bf16x8 (&qf)[2], const bf16x8 (&isel)[2], int s0, int sq, int g4,
                                          f32x4 (&o)[4], float& m_run, float& l_run) {
    const f32x4 z4 = {0.f, 0.f, 0.f, 0.f};
    f32x4 sacc[2];
#pragma unroll
    for (int hf = 0; hf < 2; ++hf) { sacc[hf] = mfma16(kf[hf][0], qf[0], z4); sacc[hf] = mfma16(kf[hf][1], qf[1], sacc[hf]); }
    const int wlo = sq - 128 > 0 ? sq - 128 : 0; const unsigned wspan = (unsigned)(sq - wlo); const int kbase = s0 + 8 * g4 - wlo;
    float tmax = -INFINITY;
#pragma unroll
    for (int hf = 0; hf < 2; ++hf)
#pragma unroll
        for (int e = 0; e < 4; ++e) { const bool ok = (unsigned)(kbase + 4 * hf + e) <= wspan;
            sacc[hf][e] = ok ? sacc[hf][e] : -INFINITY; tmax = fmaxf(tmax, sacc[hf][e]); }
    tmax = red_max_g4(tmax);
    if (__builtin_amdgcn_ballot_w64(tmax > m_run + 8.f) != 0ull) {
        const float m_new = fmaxf(m_run, tmax), m_u = (m_new == -INFINITY) ? 0.f : m_new, alpha = ex2(m_run - m_u);
        l_run *= alpha; m_run = m_new;
#pragma unroll
        for (int dvt = 0; dvt < 4; ++dvt) o[dvt] = o[dvt] * alpha;
    }
    const float m_use = (m_run == -INFINITY) ? 0.f : m_run;
    float ps = 0.f;
#pragma unroll
    for (int hf = 0; hf < 2; ++hf)
#pragma unroll
        for (int e = 0; e < 4; ++e) { sacc[hf][e] = ex2(sacc[hf][e] - m_use); ps += sacc[hf][e]; }
    l_run += ps;
    const bf16x8 pf = pack8(sacc[0], sacc[1]);
#pragma unroll
    for (int dvt = 0; dvt < 4; ++dvt) o[dvt] = mfma16(vt[dvt], pf, o[dvt]);
}
typedef short s16x4 __attribute__((ext_vector_type(4)));
template <int NT>
__device__ __forceinline__ void attn_lds_pattern(const LAS unsigned char* Kl, const LAS unsigned char* Vl, int ldsrow0, int s_lo, int sq, int c, int g4,
                                                 const bf16x8 (&qf)[2], const bf16x8 (&isel)[2], f32x4 (&o)[4], float& m_run, float& l_run) {
#pragma unroll 2
    for (int tt = 0; tt < NT; ++tt) {
        bf16x8 kf[2][2], vt[4];
#pragma unroll
        for (int hf = 0; hf < 2; ++hf) { const int off = (ldsrow0 + 32 * tt + kkmap(c, hf)) * 144 + 16 * g4;
#pragma unroll
            for (int ks = 0; ks < 2; ++ks) kf[hf][ks] = *(const LAS bf16x8*)(Kl + off + 64 * ks); }
        const LAS unsigned char* vb = Vl + (ldsrow0 + 32 * tt + 8 * g4 + (c >> 2)) * 144 + 8 * (c & 3);
#pragma unroll
        for (int dvt = 0; dvt < 4; ++dvt) {
            const s16x4 lo = __builtin_amdgcn_ds_read_tr16_b64_v4i16((LAS s16x4*)(vb + 32 * dvt)), hi = __builtin_amdgcn_ds_read_tr16_b64_v4i16((LAS s16x4*)(vb + 4 * 144 + 32 * dvt));
            vt[dvt] = __builtin_shufflevector(lo, hi, 0, 1, 2, 3, 4, 5, 6, 7);
        }
        attn_tile(kf, vt, qf, isel, s_lo + 32 * tt, sq, g4, o, m_run, l_run);
    }
}
constexpr int AL_V = 57600, AL_PT = 115200, AL_ML = AL_PT + 256 * 144;
__device__ __forceinline__ void attn_wg_unit(const Args& a, LAS unsigned char* lds, int b, int hd, int kb, int tid, int lane, int wave, const bf16x8 (&isel)[2]) {
    const bf16* Q = (const bf16*)(a.ws + WS_Q); const bf16* Kp = (const bf16*)(a.ws + WS_K); const bf16* Vp = (const bf16*)(a.ws + WS_V); bf16* mix = (bf16*)(a.ws + WS_MIX);
    const int c = lane & 15, g4 = lane >> 4, T0 = kb * 256; const size_t browbase = (size_t)b * SEQ;
    const int r1 = 4 * (wave >> 1) + (wave & 1), r2 = r1 + 2, tq1 = T0 + r1 + 16 * c, tq2 = T0 + r2 + 16 * c;
    LAS unsigned char* Kl = lds; LAS unsigned char* Vl = lds + AL_V;
    const size_t colb = (size_t)hd * 64;
    {
        u32x4 rk[7], rv[7];
#pragma unroll
        for (int i = 0; i < 7; ++i) { const int q = tid + 512 * i; if (q < 3200) { int tok = T0 - 128 + (q >> 3); tok = tok < 0 ? 0 : (tok > SEQ - 1 ? SEQ - 1 : tok);
            const size_t off = (browbase + tok) * AW + colb + (q & 7) * 8; rk[i] = *(const u32x4*)(Kp + off); rv[i] = *(const u32x4*)(Vp + off); } }
        __syncthreads();
#pragma unroll
        for (int i = 0; i < 7; ++i) { const int q = tid + 512 * i; if (q < 3200) { const int lo = (q >> 3) * 144 + (q & 7) * 16; *(LAS u32x4*)(Kl + lo) = rk[i]; *(LAS u32x4*)(Vl + lo) = rv[i]; } }
    }
    bf16x8 qf1[2], qf2[2];
#pragma unroll
    for (int ks = 0; ks < 2; ++ks) { qf1[ks] = *(const bf16x8*)(Q + (browbase + tq1) * AW + colb + 32 * ks + 8 * g4); qf2[ks] = *(const bf16x8*)(Q + (browbase + tq2) * AW + colb + 32 * ks + 8 * g4); }
    f32x4 o1[4], o2[4];
#pragma unroll
    for (int i = 0; i < 4; ++i) { o1[i] = (f32x4){0.f, 0.f, 0.f, 0.f}; o2[i] = (f32x4){0.f, 0.f, 0.f, 0.f}; }
    float m1 = -INFINITY, l1 = 0.f, m2 = -INFINITY, l2 = 0.f;
    __syncthreads();
    u32x4 bk[6], bv[6];
    auto load_b = [&](int cl0) {
#pragma unroll
        for (int i = 0; i < 6; ++i) { const int q = tid + 512 * i, j = q >> 3, ci = j >= 192 ? 1 : 0, jj = j - 192 * ci; int tok = (T0 / 4 - 128 + jj) * 4 + cl0 + ci; tok = tok < 0 ? 0 : (tok > SEQ - 1 ? SEQ - 1 : tok);
            const size_t off = (browbase + tok) * AW + colb + (q & 7) * 8; bk[i] = *(const u32x4*)(Kp + off); bv[i] = *(const u32x4*)(Vp + off); }
    };
    auto store_b = [&]() {
#pragma unroll
        for (int i = 0; i < 6; ++i) { const int q = tid + 512 * i; const int lo = (q >> 3) * 144 + (q & 7) * 16; *(LAS u32x4*)(Kl + lo) = bk[i]; *(LAS u32x4*)(Vl + lo) = bv[i]; }
    };
    load_b(0);
#pragma unroll 1
    for (int gi = 0; gi < 2; ++gi) {
        const int gq = wave + 8 * gi, tqc = T0 + 16 * gq + c;
        bf16x8 qc[2];
#pragma unroll
        for (int ks = 0; ks < 2; ++ks) qc[ks] = *(const bf16x8*)(Q + (browbase + tqc) * AW + colb + 32 * ks + 8 * g4);
        f32x4 oc[4];
#pragma unroll
        for (int i = 0; i < 4; ++i) oc[i] = (f32x4){0.f, 0.f, 0.f, 0.f};
        float mc = -INFINITY, lc = 0.f;
        attn_lds_pattern<5>(Kl, Vl, 16 * gq, T0 + 16 * gq - 128, tqc, c, g4, qc, isel, oc, mc, lc);
        lc = red_sum_g4(lc);
        LAS unsigned char* pr = lds + AL_PT + (16 * gq + c) * 144 + 8 * g4;
#pragma unroll
        for (int dvt = 0; dvt < 4; ++dvt) { u32x2 ov; ov.x = pk(oc[dvt][0], oc[dvt][1]); ov.y = pk(oc[dvt][2], oc[dvt][3]); *(LAS u32x2*)(pr + 32 * dvt) = ov; }
        if (g4 == 0) { LAS float* ml = (LAS float*)(lds + AL_ML) + 2 * (16 * gq + c); ml[0] = mc; ml[1] = lc; }
    }
    __syncthreads(); store_b(); __syncthreads();
    {
        const LAS unsigned char* p1 = lds + AL_PT + (r1 + 16 * c) * 144 + 8 * g4; const LAS unsigned char* p2 = lds + AL_PT + (r2 + 16 * c) * 144 + 8 * g4;
#pragma unroll
        for (int dvt = 0; dvt < 4; ++dvt) { const u32x2 w1 = *(const LAS u32x2*)(p1 + 32 * dvt), w2 = *(const LAS u32x2*)(p2 + 32 * dvt);
            o1[dvt] = (f32x4){bflo(w1.x), bfhi(w1.x), bflo(w1.y), bfhi(w1.y)}; o2[dvt] = (f32x4){bflo(w2.x), bfhi(w2.x), bflo(w2.y), bfhi(w2.y)}; }
        const LAS float* ml1 = (const LAS float*)(lds + AL_ML) + 2 * (r1 + 16 * c); const LAS float* ml2 = (const LAS float*)(lds + AL_ML) + 2 * (r2 + 16 * c);
        m1 = ml1[0]; l1 = (g4 == 0) ? ml1[1] : 0.f; m2 = ml2[0]; l2 = (g4 == 0) ? ml2[1] : 0.f;
    }
    load_b(2);
    attn_lds_pattern<6>(Kl, Vl, 192 * (wave & 1), T0 / 4 - 128, T0 / 4 + (r1 >> 2) + 4 * c, c, g4, qf1, isel, o1, m1, l1);
    __syncthreads(); store_b(); __syncthreads();
    attn_lds_pattern<6>(Kl, Vl, 192 * (wave & 1), T0 / 4 - 128, T0 / 4 + (r2 >> 2) + 4 * c, c, g4, qf2, isel, o2, m2, l2);
    attn_pattern<16>(Kp, Vp, browbase, hd, T0, r1, c, g4, qf1, isel, o1, m1, l1);
    attn_pattern<16>(Kp, Vp, browbase, hd, T0, r2, c, g4, qf2, isel, o2, m2, l2);
    {
        float l = l1; l = red_sum_g4(l); const float inv = 1.f / l;
        bf16* orow = mix + (browbase + tq1) * MIXW + SW + colb + 4 * g4;
#pragma unroll
        for (int dvt = 0; dvt < 4; ++dvt) { const f32x4 w = o1[dvt] * inv; u32x2 ov; ov.x = pk(w[0], w[1]); ov.y = pk(w[2], w[3]); *(u32x2*)(orow + 16 * dvt) = ov; }
    }
    {
        float l = l2; l = red_sum_g4(l); const float inv = 1.f / l;
        bf16* orow = mix + (browbase + tq2) * MIXW + SW + colb + 4 * g4;
#pragma unroll
        for (int dvt = 0; dvt < 4; ++dvt) { const f32x4 w = o2[dvt] * inv; u32x2 ov; ov.x = pk(w[0], w[1]); ov.y = pk(w[2], w[3]); *(u32x2*)(orow + 16 * dvt) = ov; }
    }
}

constexpr int YL_ACS = 0, YL_DT = 6144, YL_B = 12288, YL_X = YL_B + 128 * 272, YL_P = YL_X + 2 * 128 * 144, YL_END = YL_P + 2 * 64 * 272;
constexpr int YL_DSK = YL_END;
static_assert(YL_DSK + 64 <= 131072, "SSD LDS map");
__device__ __forceinline__ void ssd_load_x(const bf16* xbc, size_t rowbase, int h, int tid, u32x4 (&r)[2]) {
#pragma unroll
    for (int i = 0; i < 2; ++i) { const int q = tid + 512 * i; r[i] = *(const u32x4*)(xbc + (rowbase + (q >> 3)) * CD + h * 64 + (q & 7) * 8); }
}
__device__ __forceinline__ void ssd_store_x(LAS unsigned char* X, int tid, const u32x4 (&r)[2]) {
#pragma unroll
    for (int i = 0; i < 2; ++i) { const int q = tid + 512 * i; *(LAS u32x4*)(X + (q >> 3) * 144 + (q & 7) * 16) = r[i]; }
}
__device__ __forceinline__ void ssd_load_p(const bf16* Sh, int tid, u32x4 (&r)[2]) {
#pragma unroll
    for (int i = 0; i < 2; ++i) { const int q = tid + 512 * i; r[i] = *(const u32x4*)(Sh + (q >> 4) * 128 + (q & 15) * 8); }
}
__device__ __forceinline__ void ssd_store_p(LAS unsigned char* P, int tid, const u32x4 (&r)[2]) {
#pragma unroll
    for (int i = 0; i < 2; ++i) { const int q = tid + 512 * i; *(LAS u32x4*)(P + (q >> 4) * 272 + (q & 15) * 16) = r[i]; }
}
__device__ __forceinline__ void ssd_stage_common(const Args& a, LAS unsigned char* lds, size_t rowbase, int g, int tid) {
    const bf16* xbc = (const bf16*)(a.ws + WS_XBC); const float* dt = (const float*)(a.ws + WS_DT); const float* acs = (const float*)(a.ws + WS_ACS);
    u32x4 rb[4];
#pragma unroll
    for (int i = 0; i < 4; ++i) { const int q = tid + 512 * i; rb[i] = *(const u32x4*)(xbc + (rowbase + (q >> 4)) * CD + SW + g * 128 + (q & 15) * 8); }
    LAS float* acsL = (LAS float*)(lds + YL_ACS); LAS float* dtL = (LAS float*)(lds + YL_DT);
#pragma unroll
    for (int k = 0; k < 3; ++k) { const int idx = tid + 512 * k, hh = idx >> 7, sidx = idx & 127; const size_t gi = (rowbase + sidx) * NH + 12 * g + hh; acsL[idx] = acs[gi]; dtL[idx] = dt[gi]; }
#pragma unroll
    for (int i = 0; i < 4; ++i) { const int q = tid + 512 * i; *(LAS u32x4*)(lds + YL_B + (q >> 4) * 272 + (q & 15) * 16) = rb[i]; }
    if (tid < 12) ((LAS float*)(lds + YL_DSK))[tid] = a.in[10][12 * g + tid];
}

__device__ __forceinline__ void states_unit(const Args& a, LAS unsigned char* lds, int u, int tid, int lane, int wave, const bf16x8 (&isel)[2]) {
    const bf16* xbc = (const bf16*)(a.ws + WS_XBC); bf16* S = (bf16*)a.out;
    const int g = u & 1, bc = u >> 1; const size_t rowbase = (size_t)bc * 128;
    const LAS float* acsL = (const LAS float*)(lds + YL_ACS); const LAS float* dtL = (const LAS float*)(lds + YL_DT);
    const int c = lane & 15, g4 = lane >> 4, pt = wave >> 1, nh = wave & 1;
    const f32x4 z4 = {0.f, 0.f, 0.f, 0.f};
    {
        u32x4 rx[2]; ssd_load_x(xbc, rowbase, 12 * g, tid, rx);
        ssd_stage_common(a, lds, rowbase, g, tid);
        ssd_store_x(lds + YL_X, tid, rx);
    }
    __syncthreads();
    bf16x8 iselp;
#pragma unroll
    for (int j = 0; j < 8; ++j) iselp[j] = (8 * g4 + j == 16 * (pt & 1) + c) ? (short)0x3F80 : (short)0;
    bf16x8 bmT[4][4];
#pragma unroll
    for (int kt = 0; kt < 4; ++kt)
#pragma unroll
        for (int nt = 0; nt < 4; ++nt) {
            f32x4 bm[2];
#pragma unroll
            for (int hf = 0; hf < 2; ++hf) bm[hf] = mfma16(*(const LAS bf16x8*)(lds + YL_B + (32 * kt + kkmap(c, hf)) * 272 + (64 * nh + 32 * (nt >> 1) + 8 * g4) * 2), isel[nt & 1], z4);
            bmT[kt][nt] = pack8(bm[0], bm[1]);
        }
    u32x4 rxa[2], rxb[2];
    ssd_load_x(xbc, rowbase, 12 * g + 1, tid, rxb);
    auto head = [&](int hh, u32x4 (&rx_load)[2], const u32x4 (&rx_store)[2]) {
        const int h = 12 * g + hh;
        if (hh + 2 < 12) ssd_load_x(xbc, rowbase, h + 2, tid, rx_load);
        const LAS unsigned char* X = lds + YL_X + (hh & 1) * (128 * 144);
        const float acs_last = acsL[hh * 128 + 127];
        f32x4 acc[4] = {z4, z4, z4, z4};
#pragma unroll
        for (int kt = 0; kt < 4; ++kt) {
            f32x4 t[2];
#pragma unroll
            for (int hf = 0; hf < 2; ++hf) {
                const f32x4 as4 = *(const LAS f32x4*)(acsL + hh * 128 + 32 * kt + 8 * g4 + 4 * hf), dt4 = *(const LAS f32x4*)(dtL + hh * 128 + 32 * kt + 8 * g4 + 4 * hf);
                f32x4 scl;
#pragma unroll
                for (int e = 0; e < 4; ++e) scl[e] = dt4[e] * fexp(acs_last - as4[e]);
                t[hf] = mfma16(*(const LAS bf16x8*)(X + (32 * kt + kkmap(c, hf)) * 144 + (32 * (pt >> 1) + 8 * g4) * 2), iselp, z4) * scl;
            }
            const bf16x8 xT = pack8(t[0], t[1]);
#pragma unroll
            for (int nt = 0; nt < 4; ++nt) acc[nt] = mfma16(bmT[kt][nt], xT, acc[nt]);
        }
        bf16* sp = S + ((size_t)bc * NH + h) * 8192 + (size_t)(16 * pt + c) * 128 + 64 * nh + 4 * g4;
#pragma unroll
        for (int nt = 0; nt < 4; ++nt) { u32x2 ov; ov.x = pk(acc[nt][0], acc[nt][1]); ov.y = pk(acc[nt][2], acc[nt][3]); *(u32x2*)(sp + 16 * nt) = ov; }
        if (hh + 1 < 12) ssd_store_x(lds + YL_X + ((hh + 1) & 1) * (128 * 144), tid, rx_store);
        __syncthreads();
    };
#pragma unroll 1
    for (int hh = 0; hh < 12; hh += 2) { head(hh, rxa, rxb); head(hh + 1, rxb, rxa); }
}

__device__ __forceinline__ void scan_phase(const Args& a, int tid, int G) {
    const float* acs = (const float*)(a.ws + WS_ACS); bf16* S = (bf16*)a.out;
    const int NT = G * 512;
    for (int e = blockIdx.x * 512 + tid; e < 8 * NH * 64 * 32; e += NT) {
        const int n4 = e & 31, p = (e >> 5) & 63, h = (e >> 11) % NH, b = e / (2048 * NH);
        u32x2* base = (u32x2*)(S + ((size_t)(b * 64) * NH + h) * 8192 + p * 128 + 4 * n4);
        const float* ap = acs + ((size_t)b * SEQ + 127) * NH + h;
        f32x4 carry = {0.f, 0.f, 0.f, 0.f};
        u32x2 sv[2][8]; float dc[2][8];
#pragma unroll
        for (int j = 0; j < 8; ++j) { sv[0][j] = base[(size_t)j * NH * 2048]; dc[0][j] = ap[(size_t)j * 128 * NH]; }
#pragma unroll
        for (int cb = 0; cb < 8; ++cb) {
            if (cb + 1 < 8) {
#pragma unroll
                for (int j = 0; j < 8; ++j) { sv[(cb + 1) & 1][j] = base[(size_t)((cb + 1) * 8 + j) * NH * 2048]; dc[(cb + 1) & 1][j] = ap[(size_t)((cb + 1) * 8 + j) * 128 * NH]; }
            }
#pragma unroll
            for (int j = 0; j < 8; ++j) {
                const u32x2 w = sv[cb & 1][j];
                u32x2 ov; ov.x = pk(carry[0], carry[1]); ov.y = pk(carry[2], carry[3]); base[(size_t)(cb * 8 + j) * NH * 2048] = ov;
                carry = carry * fexp(dc[cb & 1][j]) + (f32x4){bflo(w.x), bfhi(w.x), bflo(w.y), bfhi(w.y)};
            }
        }
    }
}

__device__ __forceinline__ void y_unit(const Args& a, LAS unsigned char* lds, int u, int tid, int lane, int wave, const bf16x8 (&isel)[2]) {
    const bf16* xbc = (const bf16*)(a.ws + WS_XBC); const bf16* zb = (const bf16*)(a.ws + WS_Z);
    const bf16* S = (const bf16*)a.out; bf16* mix = (bf16*)(a.ws + WS_MIX);
    const int g = u & 1, bc = u >> 1; const size_t rowbase = (size_t)bc * 128;
    const LAS float* acsL = (const LAS float*)(lds + YL_ACS); const LAS float* dtL = (const LAS float*)(lds + YL_DT);
    const int lb = (wave < 4) ? wave : 11 - wave;
    const int c = lane & 15, g4 = lane >> 4, l = 16 * lb + c, ktmax = lb >> 1; const size_t myrow = rowbase + l;
    const f32x4 z4 = {0.f, 0.f, 0.f, 0.f};
    {
        u32x4 rx[2], rp[2]; ssd_load_x(xbc, rowbase, 12 * g, tid, rx); ssd_load_p(S + ((size_t)bc * NH + 12 * g) * 8192, tid, rp);
        ssd_stage_common(a, lds, rowbase, g, tid);
        ssd_store_x(lds + YL_X, tid, rx); ssd_store_p(lds + YL_P, tid, rp);
    }
    bf16x8 cf[4];
#pragma unroll
    for (int ks = 0; ks < 4; ++ks) cf[ks] = *(const bf16x8*)(xbc + myrow * CD + SW + 256 + g * 128 + 32 * ks + 8 * g4);
    __syncthreads();
    f32x4 cbt[4][2];
#pragma unroll
    for (int kt = 0; kt < 4; ++kt)
#pragma unroll
        for (int hf = 0; hf < 2; ++hf) {
            cbt[kt][hf] = z4;
            if (kt <= ktmax) {
                const LAS unsigned char* rp = lds + YL_B + (32 * kt + kkmap(c, hf)) * 272 + 16 * g4;
#pragma unroll
                for (int ks = 0; ks < 4; ++ks) cbt[kt][hf] = mfma16(*(const LAS bf16x8*)(rp + 64 * ks), cf[ks], cbt[kt][hf]);
            }
        }
    float ssq = 0.f;
    u32x4 rxa[2], rpa[2]; u32x2 xza[4];
#pragma unroll
    for (int pt = 0; pt < 4; ++pt) { const int pcol = (12 * g) * 64 + 16 * pt + 4 * g4; xza[pt] = *(const u32x2*)(zb + myrow * SW + pcol); }
    auto head = [&](int hh) {
        const int h = 12 * g + hh; const float acs_l = acsL[hh * 128 + l];
        if (hh + 1 < 12) { ssd_load_x(xbc, rowbase, h + 1, tid, rxa); ssd_load_p(S + ((size_t)bc * NH + h + 1) * 8192, tid, rpa); }
        const LAS unsigned char* X = lds + YL_X + (hh & 1) * (128 * 144); const LAS unsigned char* P = lds + YL_P + (hh & 1) * (64 * 272);
        f32x4 yT[4] = {z4, z4, z4, z4};
#pragma unroll
        for (int kt = 0; kt < 4; ++kt) {
            if (kt <= ktmax) {
                f32x4 gt[2]; bf16x8 xf[2][2];
#pragma unroll
                for (int hf = 0; hf < 2; ++hf) {
                    const f32x4 as4 = *(const LAS f32x4*)(acsL + hh * 128 + 32 * kt + 8 * g4 + 4 * hf), dt4 = *(const LAS f32x4*)(dtL + hh * 128 + 32 * kt + 8 * g4 + 4 * hf);
#pragma unroll
                    for (int e = 0; e < 4; ++e) { const int sidx = 32 * kt + 8 * g4 + 4 * hf + e; gt[hf][e] = (sidx <= l) ? cbt[kt][hf][e] * dt4[e] * fexp(fminf(acs_l - as4[e], 0.f)) : 0.f; }
                    const LAS unsigned char* xr = X + (32 * kt + kkmap(c, hf)) * 144 + 16 * g4;
                    xf[hf][0] = *(const LAS bf16x8*)xr; xf[hf][1] = *(const LAS bf16x8*)(xr + 64);
                }
                const bf16x8 gT = pack8(gt[0], gt[1]);
#pragma unroll
                for (int pt = 0; pt < 4; ++pt) {
                    const f32x4 t0 = mfma16(xf[0][pt >> 1], isel[pt & 1], z4), t1 = mfma16(xf[1][pt >> 1], isel[pt & 1], z4);
                    yT[pt] = mfma16(pack8(t0, t1), gT, yT[pt]);
                }
            }
        }
        const float el = fexp(acs_l), dsk = ((const LAS float*)(lds + YL_DSK))[hh];
#pragma unroll
        for (int pt = 0; pt < 4; ++pt) {
            f32x4 yo = z4;
#pragma unroll
            for (int ks = 0; ks < 4; ++ks) yo = mfma16(*(const LAS bf16x8*)(P + (16 * pt + c) * 272 + 64 * ks + 16 * g4), cf[ks], yo);
            const int pcol = h * 64 + 16 * pt + 4 * g4;
            const u32x2 xw = *(const LAS u32x2*)(X + l * 144 + (16 * pt + 4 * g4) * 2), zw = xza[pt];
            const f32x4 xv = {bflo(xw.x), bfhi(xw.x), bflo(xw.y), bfhi(xw.y)}, zv = {bflo(zw.x), bfhi(zw.x), bflo(zw.y), bfhi(zw.y)};
            f32x4 uo;
#pragma unroll
            for (int e = 0; e < 4; ++e) { const float yv = yT[pt][e] + el * yo[e] + dsk * xv[e]; uo[e] = yv * zv[e] * sigm(zv[e]); ssq += uo[e] * uo[e]; }
            u32x2 ov; ov.x = pk(uo[0], uo[1]); ov.y = pk(uo[2], uo[3]);
            *(u32x2*)(mix + myrow * MIXW + pcol) = ov;
        }
        if (hh + 1 < 12) {
#pragma unroll
            for (int pt = 0; pt < 4; ++pt) { const int pcol = (h + 1) * 64 + 16 * pt + 4 * g4; xza[pt] = *(const u32x2*)(zb + myrow * SW + pcol); }
            ssd_store_x(lds + YL_X + ((hh + 1) & 1) * (128 * 144), tid, rxa); ssd_store_p(lds + YL_P + ((hh + 1) & 1) * (64 * 272), tid, rpa);
        }
        __syncthreads();
    };
#pragma unroll 1
    for (int hh = 0; hh < 12; ++hh) head(hh);
    ssq = red_sum_g4(ssq);
    const float rs = rsqrtf(ssq * (1.f / 768.f) + EPS);
    if (g4 == 0) ((float*)(a.ws + WS_RS))[2 * myrow + g] = rs;
}

#define RLX_AGENT __ATOMIC_RELAXED, __HIP_MEMORY_SCOPE_AGENT
#define XB_TMO      128
#define XB_XCNT(j)  (256  + 64 * (j))
#define XB_XSUB(j)  (1280 + 64 * (j))
#define XB_XGEN(j)  (2304 + 64 * (j))
#define XB_TOP      3328
#define XB_TOPGEN   3392
#define XCD_BAR_WORDS 3456
#define XB_SPIN_CAP (1u << 18)

__device__ __forceinline__ unsigned xb_ld(unsigned* p)              { return __hip_atomic_load(p, __ATOMIC_RELAXED, __HIP_MEMORY_SCOPE_AGENT); }
__device__ __forceinline__ unsigned xb_add(unsigned* p, unsigned v) { return __hip_atomic_fetch_add(p, v, __ATOMIC_RELAXED, __HIP_MEMORY_SCOPE_AGENT); }
__device__ __forceinline__ unsigned xb_xcc_id() { return (unsigned)__builtin_amdgcn_s_getreg((3 << 11) | 20) & 0xFu; }
#define XB_SPIN(cond, bar) do { unsigned _sp = 0; while (cond) { __builtin_amdgcn_s_sleep(1); \
    if ((++_sp & 255u) == 0u) { if (xb_ld(&(bar)[XB_TMO])) break; if (_sp > XB_SPIN_CAP) { atomicAdd(&(bar)[XB_TMO], 1u); break; } } } } while (0)

struct XcdBarrier {
    unsigned* bar; unsigned x;
    volatile LAS unsigned* st;
};

__device__ __forceinline__ XcdBarrier xcd_barrier_post(unsigned* bar, volatile LAS unsigned* st) {
    XcdBarrier b; b.bar = bar; b.x = xb_xcc_id(); b.st = st;
    if (threadIdx.x == 0) (void)xb_add(&bar[XB_XCNT(b.x)], 1u);
    return b;
}
__device__ __forceinline__ void xcd_barrier_complete(unsigned* bar, unsigned x, unsigned& nloc, unsigned& nx) {
    const unsigned G = gridDim.x * gridDim.y * gridDim.z;
    unsigned sum, cnt, mine, sp = 0u;
    for (;;) {
        sum = 0u; cnt = 0u; mine = 0u;
#pragma unroll
        for (unsigned j = 0; j < 16; ++j) { const unsigned c = xb_ld(&bar[XB_XCNT(j)]); sum += c; cnt += (c > 0u) ? 1u : 0u; mine = (j == x) ? c : mine; }
        if (sum == G) break;
        __builtin_amdgcn_s_sleep(1);
        if ((++sp & 255u) == 0u) { if (xb_ld(&bar[XB_TMO])) break; if (sp > XB_SPIN_CAP) { atomicAdd(&bar[XB_TMO], 1u); break; } }
    }
    nloc = mine > 0u ? mine : 1u; nx = cnt > 0u ? cnt : 1u;
}

__device__ __forceinline__ void xcd_barrier(const XcdBarrier& b, const bool leader) {
    asm volatile("s_waitcnt vmcnt(0)" ::: "memory");
    __syncthreads();
    if (leader) {
        unsigned* bar = b.bar;
        __builtin_amdgcn_s_waitcnt(0);
        unsigned nloc = b.st[0], nx = b.st[1];
        if (nloc == 0u) { xcd_barrier_complete(bar, b.x, nloc, nx); b.st[0] = nloc; b.st[1] = nx; }
        const unsigned old = xb_add(&bar[XB_XSUB(b.x)], 1u);
        const unsigned gen = old / nloc;
        if (old + 1u == (gen + 1u) * nloc) {
            __builtin_amdgcn_fence(__ATOMIC_RELEASE, "agent");
            asm volatile("s_waitcnt vmcnt(0)" ::: "memory");
            const unsigned og = xb_add(&bar[XB_TOP], 1u);
            const unsigned tg = og / nx;
            if (og + 1u == (tg + 1u) * nx) xb_add(&bar[XB_TOPGEN], 1u);
            else XB_SPIN(xb_ld(&bar[XB_TOPGEN]) == tg, bar);
            __builtin_amdgcn_fence(__ATOMIC_ACQUIRE, "agent");
            xb_add(&bar[XB_XGEN(b.x)], 1u);
            asm volatile("s_waitcnt vmcnt(0)" ::: "memory");
        } else {
            XB_SPIN(xb_ld(&bar[XB_XGEN(b.x)]) == gen, bar);
            __builtin_amdgcn_fence(__ATOMIC_ACQUIRE, "agent");
            asm volatile("s_waitcnt vmcnt(0)" ::: "memory");
        }
    }
    __syncthreads();
}


constexpr size_t WS_BAR = 768 * 1024;
constexpr int LDS_MISC = 155648;
constexpr int LDS_BYTES = 163840;
__global__ void __launch_bounds__(512, 2) hymba_fwd(Args a) {
    __builtin_assume(__builtin_amdgcn_workitem_id_y() == 0); __builtin_assume(__builtin_amdgcn_workitem_id_z() == 0);
    extern __shared__ __attribute__((aligned(16))) unsigned char lds_raw[];
    LAS unsigned char* lds = (LAS unsigned char*)lds_raw;
    cg::grid_group grid = cg::this_grid();
    const int wave = __builtin_amdgcn_readfirstlane((int)threadIdx.x >> 6), G = gridDim.x;
#define TID_LANE int lane; asm volatile("v_mbcnt_lo_u32_b32 %0, -1, 0\n\tv_mbcnt_hi_u32_b32 %0, -1, %0" : "=v"(lane)); const int tid = wave * 64 + lane; (void)tid;
    unsigned char* ws = a.ws;
    const int lo = a.ph_lo, hi = a.ph_hi;
#define IN(k) (lo <= (k) && (k) < hi)
#if MK_N_LAUNCHES == 1
    volatile LAS unsigned* misc = (volatile LAS unsigned*)(lds + LDS_MISC);
    if (threadIdx.x < 2) misc[threadIdx.x] = 0u;
    __syncthreads();
    XcdBarrier bar = xcd_barrier_post((unsigned*)(ws + WS_BAR), misc);
#define SEAM(k) do { if (IN(k) && IN((k) + 1)) { int l_; asm volatile("v_mbcnt_lo_u32_b32 %0, -1, 0\n\tv_mbcnt_hi_u32_b32 %0, -1, %0" : "=v"(l_)); xcd_barrier(bar, wave == 0 && l_ == 0); } } while (0)
    if (hi > NPH) grid.sync();
#else
#define SEAM(k) do { } while (0)
#endif
    if (IN(0)) { TID_LANE p0_prologue(a, lds, tid, lane, wave, G); }
#ifdef PROBE_P0
    if (IN(0)) { TID_LANE p0_prologue(a, lds, tid, lane, wave, G); }
#endif
    SEAM(0);
    if (IN(1)) {
        pg8::Gemm g{(const bf16*)a.out, (const bf16*)(ws + WS_WIN), M, NP, D}; pg8::StaticOrder S; S.init(M, NP, G, (int)blockIdx.x);
        EpiInProj E{ws, a.in[4], a.in[5], a.in[8]};
        pg8::gemm_phase<EpiInProj, pg8::StaticOrder, true, true>(lds, g, S, E, wave);
    }
    SEAM(1);
    if (IN(2)) {
        TID_LANE
        for (int u = blockIdx.x; u < 256 * 8; u += G) conv_unit(a, u >> 3, u & 7, tid);
        for (int t = blockIdx.x * 8 + wave; t < 512 * NH; t += G * 8) acs_task(a, t, lane);
        bf16x8 isel[2]; make_isel(lane, isel);
#ifdef PROBE_ATT
        for (int rep = 0; rep < 2; ++rep)
#endif
        for (int u0 = blockIdx.x; u0 < 64 * 32; u0 += G) {
            int u = u0; if ((G & 7) == 0) { const int x = u0 & 7, v = u0 >> 3; u = ((v >> 5) * 8 + x) * 32 + (v & 31); }
            const int kb = u & 31, bh = u >> 5;
            attn_wg_unit(a, lds, bh >> 3, bh & 7, kb, tid, lane, wave, isel);
        }
    }
    SEAM(2);
    if (IN(3)) { TID_LANE bf16x8 isel[2]; make_isel(lane, isel);
#if defined(PROBE_SSD) || defined(PROBE_P3)
      for (int rep = 0; rep < 2; ++rep)
#endif
      for (int u0 = blockIdx.x; u0 < 1024; u0 += G) { int u = u0; if ((G & 7) == 0) { const int x = u0 & 7, v = u0 >> 3; u = x * 128 + v; }
          states_unit(a, lds, u, tid, lane, wave, isel); } }
    SEAM(3);
    if (IN(4)) { TID_LANE scan_phase(a, tid, G); }
    SEAM(4);
    if (IN(5)) { TID_LANE bf16x8 isel[2]; make_isel(lane, isel);
#ifdef PROBE_SSD
      for (int rep = 0; rep < 2; ++rep)
#endif
      for (int u0 = blockIdx.x; u0 < 1024; u0 += G) { int u = u0; if ((G & 7) == 0) { const int x = u0 & 7, v = u0 >> 3; u = x * 128 + v; }
          y_unit(a, lds, u, tid, lane, wave, isel); } }
    SEAM(5);
    if (IN(6)) {
        pg8::Gemm g{(const bf16*)(ws + WS_MIX), (const bf16*)(ws + WS_WOUT), M, D, MIXW}; pg8::StaticOrder S; S.init(M, D, G, (int)blockIdx.x);
        EpiResNorm<true> E{a.in[0], a.out, (bf16*)(ws + WS_XB), a.in[13], (float*)(ws + WS_SSQ1), (const float*)(ws + WS_RS)};
        pg8::gemm_phase<EpiResNorm<true>, pg8::StaticOrder, true, true>(lds, g, S, E, wave);
    }
    SEAM(6);
    if (IN(7)) {
        pg8::Gemm g{(const bf16*)(ws + WS_XB), (const bf16*)(ws + WS_WGU), M, 2 * FF, D}; pg8::StaticOrder S; S.init(M, 2 * FF, G, (int)blockIdx.x);
        EpiSwiGLU E{(const float*)(ws + WS_SSQ1), (bf16*)(ws + WS_HMID)};
        pg8::gemm_phase<EpiSwiGLU, pg8::StaticOrder, true, true>(lds, g, S, E, wave);
#ifdef PROBE_G3
        pg8::gemm_phase<EpiSwiGLU, pg8::StaticOrder, true, true>(lds, g, S, E, wave);
#endif
    }
    SEAM(7);
    if (IN(8)) {
        { pg8::Gemm g{(const bf16*)(ws + WS_HMID), (const bf16*)(ws + WS_WDN), M, D, FF}; pg8::StaticOrder S; S.init(M, D, G, (int)blockIdx.x);
          EpiResNorm<false> E{a.out, a.out, (bf16*)(ws + WS_XB), a.in[17], (float*)(ws + WS_SSQ2), nullptr};
          pg8::gemm_phase<EpiResNorm<false>, pg8::StaticOrder, true, true>(lds, g, S, E, wave); }
        { pg8::Gemm g{(const bf16*)(ws + WS_PB), (const bf16*)(ws + WS_WPLE), M, D, PD}; pg8::StaticOrder S; S.init(M, D, G, (int)blockIdx.x);
          EpiPle E{(bf16*)(ws + WS_T), (float*)(ws + WS_SSQT)};
          pg8::gemm_phase<EpiPle, pg8::StaticOrder, true, true>(lds, g, S, E, wave); }
    }
    SEAM(8);
    if (IN(9)) {
        pg8::Gemm g{(const bf16*)(ws + WS_XB), (const bf16*)(ws + WS_WPG), M, D, D}; pg8::StaticOrder S; S.init(M, D, G, (int)blockIdx.x);
        EpiFinal E{a.out, (const bf16*)(ws + WS_T), (const float*)(ws + WS_SSQ2), (const float*)(ws + WS_SSQT), a.in[19], a.in[21]};
        pg8::gemm_phase<EpiFinal, pg8::StaticOrder, true, true>(lds, g, S, E, wave);
    }
#undef IN
#undef SEAM
}

#ifdef DBG_STOP
__global__ void dbg_dump(const unsigned* src, float* out, size_t n) {
    for (size_t i = (size_t)blockIdx.x * blockDim.x + threadIdx.x; i < n; i += (size_t)gridDim.x * blockDim.x) {
#ifdef DBG_ATT
        if (i < (size_t)M * 256) { const unsigned u = src[(i >> 8) * 1024 + (i & 255)]; out[i] = bflo(u) + 2.f * bfhi(u); } else out[i] = 0.f;
#else
        const unsigned u = src[i]; out[i] = bflo(u) + 2.f * bfhi(u);
#endif
    }
}
#endif
extern "C" void kernel_launch(void* const* d_in, const int* in_sizes, int n_in, void* d_out, int out_size, void* d_ws, size_t ws_size, hipStream_t stream) {
    static int grid = 0;
    if (grid == 0) {
        int dev = 0, cus = 0, per_cu = 0;
        if (n_in != 22 || ws_size < WS_END) { fprintf(stderr, "kernel_launch: unexpected n_in %d / ws %zu\n", n_in, ws_size); grid = -1; return; }
        hipGetDevice(&dev); hipDeviceGetAttribute(&cus, hipDeviceAttributeMultiprocessorCount, dev);
        if (hipFuncSetAttribute((const void*)hymba_fwd, hipFuncAttributeMaxDynamicSharedMemorySize, LDS_BYTES) != hipSuccess) { fprintf(stderr, "kernel_launch: hipFuncSetAttribute failed\n"); grid = -1; return; }
        if (hipOccupancyMaxActiveBlocksPerMultiprocessor(&per_cu, (const void*)hymba_fwd, 512, LDS_BYTES) != hipSuccess || per_cu < 1) { fprintf(stderr, "kernel_launch: occupancy query says %d\n", per_cu); per_cu = 1; }
        (void)hipGetLastError();
        grid = cus * per_cu;
    }
    if (grid < 0) return;
    if (hipMemsetAsync((char*)d_ws + WS_BAR, 0, 16384, stream) != hipSuccess) { fprintf(stderr, "kernel_launch: memset of barrier words failed\n"); return; }
    Args a{};
    for (int i = 0; i < 22; ++i) a.in[i] = (const float*)d_in[i];
    a.out = (float*)d_out; a.ws = (unsigned char*)d_ws;
#if MK_N_LAUNCHES == 1
    a.ph_lo = 0; a.ph_hi = NPH;
    void* args[] = {&a};
    hipError_t e = hipLaunchCooperativeKernel((const void*)hymba_fwd, dim3(grid), dim3(512), args, LDS_BYTES, stream);
    if (e != hipSuccess) fprintf(stderr, "cooperative launch failed: %s (grid %d)\n", hipGetErrorString(e), grid);
#else
#ifdef DBG_STOP
    for (int ph = 0; ph <= DBG_STOP; ++ph) { a.ph_lo = ph; a.ph_hi = ph + 1; hipLaunchKernelGGL(hymba_fwd, dim3(grid), dim3(512), LDS_BYTES, stream, a); }
    hipLaunchKernelGGL(dbg_dump, dim3(2048), dim3(256), 0, stream, (const unsigned*)((unsigned char*)d_ws + DBG_SRC), (float*)d_out, (size_t)M * D);
#else
    for (int ph = 0; ph < NPH; ++ph) {
        a.ph_lo = ph; a.ph_hi = ph + 1;
        hipLaunchKernelGGL(hymba_fwd, dim3(grid), dim3(512), LDS_BYTES, stream, a);
    }
#endif
#endif
}
```

```cpp
#include <hip/hip_runtime.h>
#include <hip/hip_cooperative_groups.h>
#include <cstdio>
#include <cstdint>
namespace cg = cooperative_groups;
namespace pg8 {
#define PG8_LAS __attribute__((address_space(3)))
typedef unsigned short bf16_t;
typedef short bf16x8 __attribute__((ext_vector_type(8)));
typedef float f32x4 __attribute__((ext_vector_type(4)));
typedef unsigned u32x4 __attribute__((ext_vector_type(4)));
constexpr int BM = 256, BK = 64, HALF = 128, HTB = HALF * BK * 2  , STAGE_BYTES = 8 * HTB, NXCD = 8, WGM = 8;

__host__ __device__ __forceinline__ int lds_byte(int r, int c) { const int st = (r >> 4) * 2 + (c >> 5), rr = r & 15, cc = c & 31, ob = rr * 64 + cc * 2; return st * 1024 + (ob ^ (((ob >> 9) & 1) << 5)); }
__host__ __device__ __forceinline__ void stage_rc(int b, int& R, int& C) { const int st = b / 1024, sb = b % 1024, swz = sb ^ (((sb >> 9) & 1) << 5); R = (st >> 1) * 16 + swz / 64; C = (st & 1) * 32 + (swz % 64) / 2; }
__host__ __device__ __forceinline__ int perm32(int rho) { const int n = rho >> 4, i = rho & 15; return 8 * (i >> 2) + 4 * n + (i & 3); }

struct Unit { int pm, pn; };
struct Gemm { const bf16_t* A; const bf16_t* Bt; int M, N, K; };

struct StaticOrder {
    int nM, nN, nwg, G, c;
    __host__ __device__ void init(int M, int N, int G_, int c_) { nM = M / BM; nN = N / BM; nwg = nM * nN; G = G_; c = c_; }
    __host__ __device__ bool next(int i, Unit& u) const {
        const long L = (long)i * G + c; if (L >= nwg) return false;
        int wgid = (int)L; { const int q = nwg / NXCD, r = nwg % NXCD, xcd = wgid % NXCD, off = wgid / NXCD; wgid = (xcd < r ? xcd * (q + 1) : r * (q + 1) + (xcd - r) * q) + off; }
        const int nig = WGM * nN, gid = wgid / nig, fm = gid * WGM, gsz = (nM - fm) < WGM ? (nM - fm) : WGM;
        u.pm = fm + ((wgid % nig) % gsz); u.pn = (wgid % nig) / gsz; return true;
    }
    __device__ __forceinline__ void a_ready(const Unit&) const {}
    __device__ __forceinline__ void done(const Unit&) const {}
};
__device__ __forceinline__ unsigned cvt_pk_bf16(float lo, float hi) { unsigned r; asm volatile("v_cvt_pk_bf16_f32 %0, %1, %2" : "=v"(r) : "v"(lo), "v"(hi)); return r; }

template <class Epi, class Sched, bool ALIGN_EPI = false, bool SP2 = false>
__device__ __forceinline__ void gemm_phase(PG8_LAS unsigned char* lds, const Gemm g, const Sched& S, const Epi& E, const int wid) {
    int lane; asm volatile("v_mbcnt_lo_u32_b32 %0, -1, 0\n\tv_mbcnt_hi_u32_b32 %0, -1, %0" : "=v"(lane));
    const int tid = wid * 64 + lane, wr = wid >> 2, wc = wid & 3, fr = lane & 15, fq = lane >> 4;
    const int K = g.K, nt = K / BK;
    unsigned voffA[2], voffB[2];
#pragma unroll
    for (int i = 0; i < 2; ++i) { int R, C; stage_rc(tid * 16 + i * 8192, R, C); const int Rb = Epi::PERM ? ((R & ~31) + perm32(R & 31)) : R;
        voffA[i] = (unsigned)(R * K + C) * 2u; voffB[i] = (unsigned)(Rb * K + C) * 2u; }
    const size_t kstep = (size_t)(BK * 2);
    const size_t hstep = (size_t)HALF * K * 2;
    const size_t tstep = 2 * hstep;
    const unsigned ldsw = (unsigned)wid * 1024u;
    const int aoff = lds_byte(wr * 64 + fr, fq * 8), boff = lds_byte(wc * 32 + fr, fq * 8);
#define PG8_SA(b, h) (((b) * 2 + (h)) * HTB)
#define PG8_SB(b, h) ((4 + (b) * 2 + (h)) * HTB)
#define PG8_STAGE(bufoff, gbase, voff) do { _Pragma("unroll") for (int _i = 0; _i < 2; ++_i) \
        __builtin_amdgcn_global_load_lds((const unsigned*)((const char*)(gbase) + (voff)[_i]), (PG8_LAS unsigned*)(lds + (bufoff) + ldsw + _i * 8192), 16, 0, 0); } while (0)
#define PG8_LDA(dst, b, h) do { _Pragma("unroll") for (int m = 0; m < 4; ++m) _Pragma("unroll") for (int k = 0; k < 2; ++k) dst[m][k] = *(const PG8_LAS bf16x8*)(lds + PG8_SA(b, h) + aoff + m * 2048 + k * 1024); } while (0)
#define PG8_LDB(dst, b, h) do { _Pragma("unroll") for (int n = 0; n < 2; ++n) _Pragma("unroll") for (int k = 0; k < 2; ++k) dst[n][k] = *(const PG8_LAS bf16x8*)(lds + PG8_SB(b, h) + boff + n * 2048 + k * 1024); } while (0)
#define PG8_MMA(ai, bj, At, Bt) do { __builtin_amdgcn_s_setprio(1); _Pragma("unroll") for (int m = 0; m < 4; ++m) _Pragma("unroll") for (int n = 0; n < 2; ++n) _Pragma("unroll") for (int k = 0; k < 2; ++k) \
        acc[ai][bj][m][n] = __builtin_amdgcn_mfma_f32_16x16x32_bf16(Bt[n][k], At[m][k], acc[ai][bj][m][n], 0, 0, 0); __builtin_amdgcn_s_setprio(0); } while (0)
#define PG8_WAIT_V(n) asm volatile("s_waitcnt vmcnt(" #n ")" ::: "memory")
#define PG8_WAIT_L(n) asm volatile("s_waitcnt lgkmcnt(" #n ")" ::: "memory")
#define PG8_BAR __builtin_amdgcn_s_barrier()
#define PG8_SCHED __builtin_amdgcn_sched_barrier(0)
    Unit cur, nxt; int ui = 0;
    if (!S.next(0, cur)) return;
    f32x4 acc[2][2][4][2];
#pragma unroll
    for (int a = 0; a < 2; ++a)
#pragma unroll
        for (int b = 0; b < 2; ++b)
#pragma unroll
            for (int m = 0; m < 4; ++m)
#pragma unroll
                for (int n = 0; n < 2; ++n) acc[a][b][m][n] = (f32x4){0.f, 0.f, 0.f, 0.f};
    bf16x8 At[4][2], B0[2][2], B1[2][2];
    const char* cA = (const char*)g.A + (size_t)cur.pm * tstep; const char* cB = (const char*)g.Bt + (size_t)cur.pn * tstep;
    S.a_ready(cur);
    if constexpr (SP2) {
        PG8_STAGE(PG8_SB(0, 0), cB, voffB); PG8_STAGE(PG8_SB(0, 1), cB + hstep, voffB); PG8_STAGE(PG8_SA(0, 0), cA, voffA); PG8_STAGE(PG8_SA(0, 1), cA + hstep, voffA);
        if (wr == 1) PG8_BAR;
        PG8_WAIT_V(2); PG8_BAR;
        PG8_STAGE(PG8_SB(1, 0), cB + kstep, voffB); PG8_STAGE(PG8_SA(1, 0), cA + kstep, voffA); PG8_STAGE(PG8_SB(1, 1), cB + hstep + kstep, voffB);
        PG8_WAIT_V(6); PG8_BAR;
    } else {
        PG8_STAGE(PG8_SB(0, 0), cB, voffB); PG8_STAGE(PG8_SA(0, 0), cA, voffA); PG8_STAGE(PG8_SB(0, 1), cB + hstep, voffB); PG8_STAGE(PG8_SA(0, 1), cA + hstep, voffA);
        if (wr == 1) PG8_BAR;
        PG8_WAIT_V(4); PG8_BAR;
        PG8_STAGE(PG8_SB(1, 0), cB + kstep, voffB); PG8_STAGE(PG8_SA(1, 0), cA + kstep, voffA); PG8_STAGE(PG8_SB(1, 1), cB + hstep + kstep, voffB);
        PG8_WAIT_V(6); PG8_BAR;
    }
    for (;;) {
        const bool has_next = S.next(ui + 1, nxt);
        const char* nA = has_next ? (const char*)g.A + (size_t)nxt.pm * tstep : cA; const char* nB = has_next ? (const char*)g.Bt + (size_t)nxt.pn * tstep : cB;
        for (int t = 0; t < nt; t += 2) {
            if constexpr (Epi::HAS_HOOK) E.hook(t, acc, cur, wr, fr);
            const bool last = (t == nt - 2);
            const char* a1 = cA + (size_t)(t + 1) * kstep;
            const char* a2 = last ? nA : cA + (size_t)(t + 2) * kstep; const char* b2 = last ? nB : cB + (size_t)(t + 2) * kstep;
            const char* a3 = a2 + kstep; const char* b3 = b2 + kstep;
            if (last && has_next) S.a_ready(nxt);
            if constexpr (SP2) {
            PG8_LDB(B0, 0, 0); PG8_LDB(B1, 0, 1); PG8_SCHED; PG8_LDA(At, 0, 0); PG8_STAGE(PG8_SA(1, 1), a1 + hstep, voffA);
            PG8_WAIT_V(8); PG8_WAIT_L(0); PG8_BAR; PG8_MMA(0, 0, At, B0); PG8_MMA(0, 1, At, B1); PG8_BAR; PG8_SCHED;
            PG8_LDA(At, 0, 1); PG8_STAGE(PG8_SB(0, 0), b2, voffB); PG8_STAGE(PG8_SB(0, 1), b2 + hstep, voffB); PG8_STAGE(PG8_SA(0, 0), a2, voffA);
            PG8_WAIT_V(8); PG8_WAIT_L(0); PG8_BAR; PG8_MMA(1, 0, At, B0); PG8_MMA(1, 1, At, B1); PG8_BAR; PG8_SCHED;
            PG8_LDB(B0, 1, 0); PG8_LDB(B1, 1, 1); PG8_SCHED; PG8_LDA(At, 1, 0); PG8_STAGE(PG8_SA(0, 1), a2 + hstep, voffA);
            PG8_WAIT_V(8); PG8_WAIT_L(0); PG8_BAR; PG8_MMA(0, 0, At, B0); PG8_MMA(0, 1, At, B1); PG8_BAR; PG8_SCHED;
            PG8_LDA(At, 1, 1); PG8_STAGE(PG8_SB(1, 0), b3, voffB); PG8_STAGE(PG8_SB(1, 1), b3 + hstep, voffB); PG8_STAGE(PG8_SA(1, 0), a3, voffA);
            PG8_WAIT_V(8); PG8_WAIT_L(0); PG8_BAR; PG8_MMA(1, 0, At, B0); PG8_MMA(1, 1, At, B1); PG8_BAR; PG8_SCHED;
            } else {
            PG8_LDB(B0, 0, 0); PG8_SCHED; PG8_LDA(At, 0, 0); PG8_STAGE(PG8_SA(1, 1), a1 + hstep, voffA);
            PG8_WAIT_L(8); PG8_BAR; PG8_WAIT_L(0); PG8_MMA(0, 0, At, B0); PG8_BAR; PG8_SCHED;
            PG8_LDB(B1, 0, 1); PG8_STAGE(PG8_SB(0, 0), b2, voffB);
            PG8_BAR; PG8_WAIT_L(0); PG8_MMA(0, 1, At, B1); PG8_BAR;
            PG8_LDA(At, 0, 1); PG8_STAGE(PG8_SA(0, 0), a2, voffA);
            PG8_BAR; PG8_WAIT_L(0); PG8_MMA(1, 0, At, B0); PG8_BAR; PG8_SCHED;
            PG8_STAGE(PG8_SB(0, 1), b2 + hstep, voffB);
            PG8_WAIT_V(6); PG8_BAR; PG8_MMA(1, 1, At, B1); PG8_BAR;
            PG8_LDB(B0, 1, 0); PG8_SCHED; PG8_LDA(At, 1, 0); PG8_STAGE(PG8_SA(0, 1), a2 + hstep, voffA);
            PG8_WAIT_L(8); PG8_BAR; PG8_WAIT_L(0); PG8_MMA(0, 0, At, B0); PG8_BAR; PG8_SCHED;
            PG8_LDB(B1, 1, 1); PG8_STAGE(PG8_SB(1, 0), b3, voffB);
            PG8_BAR; PG8_WAIT_L(0); PG8_MMA(0, 1, At, B1); PG8_BAR;
            PG8_LDA(At, 1, 1); PG8_STAGE(PG8_SA(1, 0), a3, voffA);
            PG8_BAR; PG8_WAIT_L(0); PG8_MMA(1, 0, At, B0); PG8_BAR; PG8_SCHED;
            PG8_STAGE(PG8_SB(1, 1), b3 + hstep, voffB);
            PG8_WAIT_V(6); PG8_BAR; PG8_MMA(1, 1, At, B1); PG8_BAR;
            }
        }
        if constexpr (ALIGN_EPI) { if (wr == 0) PG8_BAR; }
        if constexpr (!Epi::AFTER_DRAIN) { E(acc, cur, wr, wc, fr, fq); S.done(cur); }
        if (!has_next) break;
#pragma unroll
        for (int a = 0; a < 2; ++a)
#pragma unroll
            for (int b = 0; b < 2; ++b)
#pragma unroll
                for (int m = 0; m < 4; ++m)
#pragma unroll
                    for (int n = 0; n < 2; ++n) acc[a][b][m][n] = (f32x4){0.f, 0.f, 0.f, 0.f};
        cur = nxt; cA = nA; cB = nB; ++ui;
        if constexpr (ALIGN_EPI) { if (wr == 1) PG8_BAR; }
    }
    PG8_WAIT_V(0);
    if constexpr (!ALIGN_EPI) { if (wr == 0) PG8_BAR; }
    PG8_BAR;
    if constexpr (Epi::AFTER_DRAIN) { E.fused(acc, cur, wr, wc, fr, fq, lds, wid, lane); S.done(cur); }
#undef PG8_SA
#undef PG8_SB
#undef PG8_STAGE
#undef PG8_LDA
#undef PG8_LDB
#undef PG8_MMA
#undef PG8_WAIT_V
#undef PG8_WAIT_L
#undef PG8_BAR
#undef PG8_SCHED
}
}

#ifndef MK_N_LAUNCHES
#define MK_N_LAUNCHES 1
#endif
constexpr int M = 65536, SEQ = 8192, D = 1024, NPROJ = 5144, NP = 5376, AW = 512, SW = 1536, CD = 2048, FF = 2816, PD = 256, NH = 24, MIXW = 2048;
constexpr int NPH = 10;
constexpr float EPS = 1e-6f;
constexpr float LOG2E = 1.4426950408889634f;
constexpr size_t MiB = 1u << 20;
constexpr size_t WS_SSQ1 = 0, WS_SSQ2 = 256 * 1024, WS_SSQT = 512 * 1024;
constexpr size_t WS_HALO = 1 * MiB;
constexpr size_t WS_DT = 4 * MiB, WS_ACS = 10 * MiB;
constexpr size_t WS_WIN = 16 * MiB, WS_WOUT = 27 * MiB, WS_WGU = 31 * MiB, WS_WDN = 42 * MiB, WS_WPG = 48 * MiB, WS_WPLE = 50 * MiB;
constexpr size_t WS_PB = 52 * MiB;
constexpr size_t WS_Q = 84 * MiB, WS_K = 148 * MiB, WS_V = 212 * MiB;
constexpr size_t WS_Z = 276 * MiB;
constexpr size_t WS_XBC = 468 * MiB;
constexpr size_t WS_MIX = 724 * MiB;
constexpr size_t WS_RS = 980 * MiB;
constexpr size_t WS_END = 981 * MiB;
constexpr size_t WS_XB = WS_Q;
constexpr size_t WS_HMID = WS_Z;
constexpr size_t WS_T = WS_MIX;
static_assert(WS_HMID + (size_t)M * FF * 2 <= WS_MIX, "hmid overlay");

#define LAS __attribute__((address_space(3)))
typedef unsigned short bf16;
using pg8::bf16x8; using pg8::f32x4; using pg8::u32x4; using pg8::Unit;
typedef unsigned u32x2 __attribute__((ext_vector_type(2)));

typedef float f32x2_t __attribute__((ext_vector_type(2)));
typedef __bf16 bf16x2_t __attribute__((ext_vector_type(2)));
__device__ __forceinline__ unsigned pk(float lo, float hi) { f32x2_t v = {lo, hi}; bf16x2_t b = __builtin_convertvector(v, bf16x2_t); return __builtin_bit_cast(unsigned, b); }
__device__ __forceinline__ bf16x8 pack8(f32x4 a, f32x4 b) { u32x4 w; w.x = pk(a[0], a[1]); w.y = pk(a[2], a[3]); w.z = pk(b[0], b[1]); w.w = pk(b[2], b[3]); return __builtin_bit_cast(bf16x8, w); }
__device__ __forceinline__ u32x4 pack8u(f32x4 a, f32x4 b) { u32x4 w; w.x = pk(a[0], a[1]); w.y = pk(a[2], a[3]); w.z = pk(b[0], b[1]); w.w = pk(b[2], b[3]); return w; }
__device__ __forceinline__ float bflo(unsigned u) { return __uint_as_float(u << 16); }
__device__ __forceinline__ float bfhi(unsigned u) { return __uint_as_float(u & 0xffff0000u); }
__device__ __forceinline__ float ex2(float x) { return __builtin_amdgcn_exp2f(x); }
__device__ __forceinline__ float fexp(float x) { return __builtin_amdgcn_exp2f(x * LOG2E); }
__device__ __forceinline__ float sigm(float x) { return __builtin_amdgcn_rcpf(1.f + fexp(-x)); }
__device__ __forceinline__ f32x4 mfma16(bf16x8 a, bf16x8 b, f32x4 c) { return __builtin_amdgcn_mfma_f32_16x16x32_bf16(a, b, c, 0, 0, 0); }
__device__ __forceinline__ float wave_sum(float v) {
#pragma unroll
    for (int o = 1; o < 64; o <<= 1) v += __shfl_xor(v, o);
    return v;
}
typedef unsigned u32x2s __attribute__((ext_vector_type(2)));
__device__ __forceinline__ float red_max_g4(float x) {
    const unsigned u = __float_as_uint(x); const u32x2s r = __builtin_amdgcn_permlane16_swap(u, u, false, false);
    const float m = fmaxf(__uint_as_float(r.x), __uint_as_float(r.y));
    const unsigned v = __float_as_uint(m); const u32x2s s = __builtin_amdgcn_permlane32_swap(v, v, false, false);
    return fmaxf(__uint_as_float(s.x), __uint_as_float(s.y));
}
__device__ __forceinline__ float red_sum_g4(float x) {
    const unsigned u = __float_as_uint(x); const u32x2s r = __builtin_amdgcn_permlane16_swap(u, u, false, false);
    const float m = __uint_as_float(r.x) + __uint_as_float(r.y);
    const unsigned v = __float_as_uint(m); const u32x2s s = __builtin_amdgcn_permlane32_swap(v, v, false, false);
    return __uint_as_float(s.x) + __uint_as_float(s.y);
}
__device__ __forceinline__ int kkmap(int m, int hf) { return 8 * (m >> 2) + 4 * hf + (m & 3); }

struct EpiInProj {
    static constexpr bool PERM = true, AFTER_DRAIN = false, HAS_HOOK = false;
    unsigned char* ws; const float *qn, *kn, *dtb;
    __device__ __forceinline__ void operator()(const f32x4 (&acc)[2][2][4][2], const Unit& u, int wr, int wc, int fr, int fq) const {
        const int pn = u.pn; const int row0 = u.pm * 256 + wr * 64 + fr;
        if (pn < 4) {
            const bool isq = pn < 2; const float* gn = isq ? qn : kn; bf16* dst = (bf16*)(ws + (isq ? WS_Q : WS_K));
            const float sc = isq ? 0.125f * LOG2E : 1.f;
            const int hd = 4 * (pn & 1) + wc;
            f32x4 gv[2][2];
#pragma unroll
            for (int bj = 0; bj < 2; ++bj)
#pragma unroll
                for (int n = 0; n < 2; ++n) gv[bj][n] = *(const f32x4*)(gn + 32 * bj + 8 * fq + 4 * n) * sc;
#pragma unroll
            for (int ai = 0; ai < 2; ++ai)
#pragma unroll
                for (int m = 0; m < 4; ++m) {
                    float ss = 0.f;
#pragma unroll
                    for (int bj = 0; bj < 2; ++bj)
#pragma unroll
                        for (int n = 0; n < 2; ++n) { const f32x4 x = acc[ai][bj][m][n]; ss += (x[0] * x[0] + x[1] * x[1]) + (x[2] * x[2] + x[3] * x[3]); }
                    ss = red_sum_g4(ss);
                    const float rs = rsqrtf(ss * (1.f / 64.f) + EPS);
                    bf16* rowp = dst + (size_t)(row0 + ai * 128 + m * 16) * AW + hd * 64 + 8 * fq;
#pragma unroll
                    for (int bj = 0; bj < 2; ++bj) *(u32x4*)(rowp + 32 * bj) = pack8u(acc[ai][bj][m][0] * rs * gv[bj][0], acc[ai][bj][m][1] * rs * gv[bj][1]);
                }
        } else if (pn < 20) {
            int ldc, colt; size_t woff;
            if (pn < 6) { woff = WS_V; ldc = AW; colt = (pn - 4) * 256; } else if (pn < 12) { woff = WS_Z; ldc = SW; colt = (pn - 6) * 256; } else { woff = WS_XBC; ldc = CD; colt = (pn - 12) * 256; }
            bf16* dst = (bf16*)(ws + woff);
            const int col0 = colt + wc * 32 + 8 * fq;
#pragma unroll
            for (int ai = 0; ai < 2; ++ai)
#pragma unroll
                for (int m = 0; m < 4; ++m) {
                    bf16* rowp = dst + (size_t)(row0 + ai * 128 + m * 16) * ldc + col0;
#pragma unroll
                    for (int bj = 0; bj < 2; ++bj) *(u32x4*)(rowp + bj * 128) = pack8u(acc[ai][bj][m][0], acc[ai][bj][m][1]);
                }
            if (pn >= 12 && wr == 1 && fr >= 13) {
                bf16* hp = (bf16*)(ws + WS_HALO) + ((size_t)u.pm * 3 + (fr - 13)) * CD + col0;
#pragma unroll
                for (int bj = 0; bj < 2; ++bj) *(u32x4*)(hp + bj * 128) = pack8u(acc[1][bj][3][0], acc[1][bj][3][1]);
            }
        } else {
            if (wc == 0 && fq < 3) {
                f32x4 bv[2];
#pragma unroll
                for (int n = 0; n < 2; ++n) bv[n] = *(const f32x4*)(dtb + 8 * fq + 4 * n);
#pragma unroll
                for (int ai = 0; ai < 2; ++ai)
#pragma unroll
                    for (int m = 0; m < 4; ++m) {
                        float* rowp = (float*)(ws + WS_DT) + (size_t)(row0 + ai * 128 + m * 16) * NH + 8 * fq;
#pragma unroll
                        for (int n = 0; n < 2; ++n) { f32x4 x = acc[ai][0][m][n] + bv[n], o;
#pragma unroll
                            for (int e = 0; e < 4; ++e) o[e] = fmaxf(x[e], 0.f) + log1pf(fexp(-fabsf(x[e])));
                            *(f32x4*)(rowp + 4 * n) = o; }
                    }
            }
        }
    }
};

template <bool HOOK> struct EpiResNorm {
    static constexpr bool PERM = true, AFTER_DRAIN = false, HAS_HOOK = HOOK;
    const float* base; float* out; bf16* xb; const float* gain; float* ssq; const float* rsg;
    __device__ __forceinline__ void hook(int t, f32x4 (&acc)[2][2][4][2], const Unit& u, int wr, int fr) const {
        if (t != 12 && t != 24) return;
        const int row0 = u.pm * 256 + wr * 64 + fr;
#pragma unroll
        for (int ai = 0; ai < 2; ++ai)
#pragma unroll
            for (int m = 0; m < 4; ++m) {
                const float r0 = rsg[2 * (row0 + ai * 128 + m * 16)], r1 = rsg[2 * (row0 + ai * 128 + m * 16) + 1];
                const float sc = (t == 12) ? r0 / r1 : r1;
#pragma unroll
                for (int bj = 0; bj < 2; ++bj)
#pragma unroll
                    for (int n = 0; n < 2; ++n) acc[ai][bj][m][n] *= sc;
            }
    }
    __device__ __forceinline__ void operator()(const f32x4 (&acc)[2][2][4][2], const Unit& u, int wr, int wc, int fr, int fq) const {
        const int row0 = u.pm * 256 + wr * 64 + fr, col0 = u.pn * 256 + wc * 32 + 8 * fq;
        f32x4 gv[2][2];
#pragma unroll
        for (int bj = 0; bj < 2; ++bj)
#pragma unroll
            for (int n = 0; n < 2; ++n) gv[bj][n] = *(const f32x4*)(gain + col0 + bj * 128 + 4 * n);
        f32x4 xin[2][2][2];
#pragma unroll
        for (int bj = 0; bj < 2; ++bj)
#pragma unroll
            for (int n = 0; n < 2; ++n) xin[0][bj][n] = *(const f32x4*)(base + (size_t)row0 * D + col0 + bj * 128 + 4 * n);
#pragma unroll
        for (int i = 0; i < 8; ++i) {
            const int ai = i >> 2, m = i & 3, r = row0 + ai * 128 + m * 16;
            if (i + 1 < 8) { const int rn = row0 + ((i + 1) >> 2) * 128 + ((i + 1) & 3) * 16;
#pragma unroll
                for (int bj = 0; bj < 2; ++bj)
#pragma unroll
                    for (int n = 0; n < 2; ++n) xin[(i + 1) & 1][bj][n] = *(const f32x4*)(base + (size_t)rn * D + col0 + bj * 128 + 4 * n); }
            float ss = 0.f;
#pragma unroll
            for (int bj = 0; bj < 2; ++bj) {
                const size_t off = (size_t)r * D + col0 + bj * 128;
                const f32x4 v0 = xin[i & 1][bj][0] + acc[ai][bj][m][0], v1 = xin[i & 1][bj][1] + acc[ai][bj][m][1];
                *(f32x4*)(out + off) = v0; *(f32x4*)(out + off + 4) = v1;
                ss += (v0[0] * v0[0] + v0[1] * v0[1]) + (v0[2] * v0[2] + v0[3] * v0[3]) + (v1[0] * v1[0] + v1[1] * v1[1]) + (v1[2] * v1[2] + v1[3] * v1[3]);
                *(u32x4*)(xb + off) = pack8u(v0 * gv[bj][0], v1 * gv[bj][1]);
            }
            ss = red_sum_g4(ss);
            if (fq == 0) unsafeAtomicAdd(ssq + r, ss);
        }
    }
};

struct EpiSwiGLU {
    static constexpr bool PERM = true, AFTER_DRAIN = false, HAS_HOOK = false;
    const float* ssq; bf16* h;
    __device__ __forceinline__ void operator()(const f32x4 (&acc)[2][2][4][2], const Unit& u, int wr, int wc, int fr, int fq) const {
        const int row0 = u.pm * 256 + wr * 64 + fr, col0 = u.pn * 128 + wc * 32 + 8 * fq;
        float sq8[2][4];
#pragma unroll
        for (int ai = 0; ai < 2; ++ai)
#pragma unroll
            for (int m = 0; m < 4; ++m) sq8[ai][m] = ssq[row0 + ai * 128 + m * 16];
#pragma unroll
        for (int ai = 0; ai < 2; ++ai)
#pragma unroll
            for (int m = 0; m < 4; ++m) {
                const int r = row0 + ai * 128 + m * 16;
                const float rs = rsqrtf(sq8[ai][m] * (1.f / D) + EPS);
                f32x4 hv[2];
#pragma unroll
                for (int n = 0; n < 2; ++n) { const f32x4 g = acc[ai][0][m][n] * rs, uu = acc[ai][1][m][n] * rs;
#pragma unroll
                    for (int e = 0; e < 4; ++e) hv[n][e] = g[e] * sigm(g[e]) * uu[e]; }
                *(u32x4*)(h + (size_t)r * FF + col0) = pack8u(hv[0], hv[1]);
            }
    }
};

struct EpiPle {
    static constexpr bool PERM = true, AFTER_DRAIN = false, HAS_HOOK = false;
    bf16* t; float* ssq;
    __device__ __forceinline__ void operator()(const f32x4 (&acc)[2][2][4][2], const Unit& u, int wr, int wc, int fr, int fq) const {
        const int row0 = u.pm * 256 + wr * 64 + fr, col0 = u.pn * 256 + wc * 32 + 8 * fq;
#pragma unroll
        for (int ai = 0; ai < 2; ++ai)
#pragma unroll
            for (int m = 0; m < 4; ++m) {
                const int r = row0 + ai * 128 + m * 16; float ss = 0.f;
#pragma unroll
                for (int bj = 0; bj < 2; ++bj) {
                    const f32x4 v0 = acc[ai][bj][m][0], v1 = acc[ai][bj][m][1];
                    ss += (v0[0] * v0[0] + v0[1] * v0[1]) + (v0[2] * v0[2] + v0[3] * v0[3]) + (v1[0] * v1[0] + v1[1] * v1[1]) + (v1[2] * v1[2] + v1[3] * v1[3]);
                    *(u32x4*)(t + (size_t)r * D + col0 + bj * 128) = pack8u(v0, v1);
                }
                ss = red_sum_g4(ss);
                if (fq == 0) unsafeAtomicAdd(ssq + r, ss);
            }
    }
};

struct EpiFinal {
    static constexpr bool PERM = true, AFTER_DRAIN = false, HAS_HOOK = false;
    float* out; const bf16* t; const float *ssq2, *ssqt, *bias, *png;
    __device__ __forceinline__ void operator()(const f32x4 (&acc)[2][2][4][2], const Unit& u, int wr, int wc, int fr, int fq) const {
        const int row0 = u.pm * 256 + wr * 64 + fr, col0 = u.pn * 256 + wc * 32 + 8 * fq;
        f32x4 bv[2][2], gv[2][2];
#pragma unroll
        for (int bj = 0; bj < 2; ++bj)
#pragma unroll
            for (int n = 0; n < 2; ++n) { bv[bj][n] = *(const f32x4*)(bias + col0 + bj * 128 + 4 * n); gv[bj][n] = *(const f32x4*)(png + col0 + bj * 128 + 4 * n); }
        f32x4 xin[2][2][2]; u32x4 tin[2][2]; float q2[2], qt[2];
        q2[0] = ssq2[row0]; qt[0] = ssqt[row0];
#pragma unroll
        for (int bj = 0; bj < 2; ++bj) { const size_t off = (size_t)row0 * D + col0 + bj * 128; tin[0][bj] = *(const u32x4*)(t + off); xin[0][bj][0] = *(const f32x4*)(out + off); xin[0][bj][1] = *(const f32x4*)(out + off + 4); }
#pragma unroll
        for (int i = 0; i < 8; ++i) {
            const int ai = i >> 2, m = i & 3, r = row0 + ai * 128 + m * 16;
            if (i + 1 < 8) { const int rn = row0 + ((i + 1) >> 2) * 128 + ((i + 1) & 3) * 16; q2[(i + 1) & 1] = ssq2[rn]; qt[(i + 1) & 1] = ssqt[rn];
#pragma unroll
                for (int bj = 0; bj < 2; ++bj) { const size_t off = (size_t)rn * D + col0 + bj * 128; tin[(i + 1) & 1][bj] = *(const u32x4*)(t + off); xin[(i + 1) & 1][bj][0] = *(const f32x4*)(out + off); xin[(i + 1) & 1][bj][1] = *(const f32x4*)(out + off + 4); } }
            const float rs2 = rsqrtf(q2[i & 1] * (1.f / D) + EPS), rst = rsqrtf(qt[i & 1] * (1.f / D) + EPS);
#pragma unroll
            for (int bj = 0; bj < 2; ++bj) {
                const size_t off = (size_t)r * D + col0 + bj * 128;
                const u32x4 tw = tin[i & 1][bj];
                f32x4 tv[2] = {{bflo(tw.x), bfhi(tw.x), bflo(tw.y), bfhi(tw.y)}, {bflo(tw.z), bfhi(tw.z), bflo(tw.w), bfhi(tw.w)}};
#pragma unroll
                for (int n = 0; n < 2; ++n) {
                    const f32x4 x2 = xin[i & 1][bj][n]; const f32x4 a = acc[ai][bj][m][n] * rs2 + bv[bj][n]; f32x4 o;
#pragma unroll
                    for (int e = 0; e < 4; ++e) o[e] = x2[e] + sigm(a[e]) * (tv[n][e] * rst * gv[bj][n][e]);
                    *(f32x4*)(out + off + 4 * n) = o;
                }
            }
        }
    }
};

__device__ __forceinline__ void make_isel(int lane, bf16x8 (&isel)[2]) {
    const int c = lane & 15, g4 = lane >> 4;
#pragma unroll
    for (int o = 0; o < 2; ++o)
#pragma unroll
        for (int j = 0; j < 8; ++j) isel[o][j] = (8 * g4 + j == 16 * o + c) ? (short)0x3F80 : (short)0;
}
struct Args { const float* in[22]; float* out; unsigned char* ws; int ph_lo, ph_hi; };

__device__ __forceinline__ void transpose_item(const float* colp, int ld, int K, bf16* WT, int k0, int n0, LAS float* scr, int lane, const float* kgain = nullptr) {
#pragma unroll 8
    for (int i = 0; i < 32; ++i) { const int kk = 2 * i + (lane >> 5); const float gsc = kgain ? kgain[k0 + kk] : 1.f; scr[kk * 33 + (lane & 31)] = colp ? colp[(ptrdiff_t)(k0 + kk) * ld] * gsc : 0.f; }
    asm volatile("s_waitcnt lgkmcnt(0)" ::: "memory");
    const int c = lane & 7;
#pragma unroll
    for (int j = 0; j < 4; ++j) { const int n = (lane >> 3) + 8 * j; const LAS float* s = scr + (8 * c) * 33 + n;
        u32x4 o; o.x = pk(s[0 * 33], s[1 * 33]); o.y = pk(s[2 * 33], s[3 * 33]); o.z = pk(s[4 * 33], s[5 * 33]); o.w = pk(s[6 * 33], s[7 * 33]);
        *(u32x4*)(WT + (size_t)(n0 + n) * K + k0 + 8 * c) = o; }
    asm volatile("s_waitcnt lgkmcnt(0)" ::: "memory");
}

__device__ __forceinline__ void p0_prologue(const Args& a, LAS unsigned char* lds, int tid, int lane, int wave, int G) {
    unsigned char* ws = a.ws;
    LAS float* scr = (LAS float*)(lds + wave * 16384);
    const int gw = blockIdx.x * 8 + wave, NGW = G * 8;
    constexpr int I_IN = (D / 64) * (NP / 32), I_OUT = (MIXW / 64) * (D / 32), I_GU = (D / 64) * (2 * FF / 32), I_DN = (FF / 64) * (D / 32), I_PG = (D / 64) * (D / 32), I_PLE = (PD / 64) * (D / 32);
    constexpr int NITEMS = I_IN + I_OUT + I_GU + I_DN + I_PG + I_PLE;
    for (int it = gw; it < NITEMS; it += NGW) {
        int r = it;
        if (r < I_IN) {
            const int nblk = NP / 32, kb = r / nblk, nb = r % nblk, np = nb * 32 + (lane & 31); int col;
            if (np < 1024) { const int seg = np >> 9, p = np & 511, tile = p >> 8, pos = p & 255, bj = pos >> 7, wc = (pos & 127) >> 5, j = pos & 31; col = seg * 512 + (4 * tile + wc) * 64 + 32 * bj + j; }
            else col = np;
            transpose_item(col < NPROJ ? a.in[3] + col : nullptr, NPROJ, D, (bf16*)(ws + WS_WIN), 64 * kb, 32 * nb, scr, lane); continue; }
        r -= I_IN;
        if (r < I_OUT) {
            const int nblk = D / 32, kb = r / nblk, nb = r % nblk, k0 = 64 * kb; const int srck0 = k0 < SW ? AW + k0 : k0 - SW;
            transpose_item(a.in[12] + (ptrdiff_t)(srck0 - k0) * D + nb * 32 + (lane & 31), D, MIXW, (bf16*)(ws + WS_WOUT), k0, 32 * nb, scr, lane, k0 < SW ? a.in[11] : nullptr); continue; }
        r -= I_OUT;
        if (r < I_GU) {
            const int nblk = 2 * FF / 32, kb = r / nblk, nb = r % nblk, np = nb * 32 + (lane & 31);
            const int pn = np >> 8, pos = np & 255, bj = pos >> 7, wc = (pos & 127) >> 5, j = pos & 31, ff = 128 * pn + 32 * wc + j;
            transpose_item((bj ? a.in[15] : a.in[14]) + ff, FF, D, (bf16*)(ws + WS_WGU), 64 * kb, 32 * nb, scr, lane); continue; }
        r -= I_GU;
        if (r < I_DN) { const int nblk = D / 32, kb = r / nblk, nb = r % nblk; transpose_item(a.in[16] + nb * 32 + (lane & 31), D, FF, (bf16*)(ws + WS_WDN), 64 * kb, 32 * nb, scr, lane); continue; }
        r -= I_DN;
        if (r < I_PG) { const int nblk = D / 32, kb = r / nblk, nb = r % nblk; transpose_item(a.in[18] + nb * 32 + (lane & 31), D, D, (bf16*)(ws + WS_WPG), 64 * kb, 32 * nb, scr, lane); continue; }
        r -= I_PG;
        { const int nblk = D / 32, kb = r / nblk, nb = r % nblk; transpose_item(a.in[20] + nb * 32 + (lane & 31), D, PD, (bf16*)(ws + WS_WPLE), 64 * kb, 32 * nb, scr, lane); }
    }
    {
        bf16* h0 = (bf16*)a.out; const float* x = a.in[0]; const float* gn = a.in[2];
        f32x4 g4v[4];
#pragma unroll
        for (int j = 0; j < 4; ++j) g4v[j] = *(const f32x4*)(gn + 4 * (64 * j + lane));
        for (int m0 = gw; m0 < M; m0 += 4 * NGW) {
            f32x4 v[4][4];
#pragma unroll
            for (int rr = 0; rr < 4; ++rr) { const int m = m0 + rr * NGW; if (m < M) { const f32x4* xr = (const f32x4*)(x + (size_t)m * D) + lane;
#pragma unroll
                for (int j = 0; j < 4; ++j) v[rr][j] = xr[64 * j]; } }
#pragma unroll
            for (int rr = 0; rr < 4; ++rr) { const int m = m0 + rr * NGW; if (m < M) {
                float sacc = 0.f;
#pragma unroll
                for (int j = 0; j < 4; ++j) sacc += (v[rr][j][0] * v[rr][j][0] + v[rr][j][1] * v[rr][j][1]) + (v[rr][j][2] * v[rr][j][2] + v[rr][j][3] * v[rr][j][3]);
                const float rs = rsqrtf(wave_sum(sacc) * (1.f / D) + EPS);
                u32x2* o8 = (u32x2*)(h0 + (size_t)m * D) + lane;
#pragma unroll
                for (int j = 0; j < 4; ++j) { const f32x4 w = v[rr][j] * rs * g4v[j]; u32x2 o; o.x = pk(w[0], w[1]); o.y = pk(w[2], w[3]); o8[64 * j] = o; } } }
        }
    }
    {
        const int gt = blockIdx.x * 512 + tid, NT = G * 512;
        const f32x4* p4 = (const f32x4*)a.in[1]; u32x4* pb = (u32x4*)(ws + WS_PB);
        for (int i0 = gt; i0 < M * PD / 8; i0 += 4 * NT) {
            f32x4 v[4][2];
#pragma unroll
            for (int j = 0; j < 4; ++j) { const int i = i0 + j * NT; if (i < M * PD / 8) { v[j][0] = p4[2 * i]; v[j][1] = p4[2 * i + 1]; } }
#pragma unroll
            for (int j = 0; j < 4; ++j) { const int i = i0 + j * NT; if (i < M * PD / 8) pb[i] = pack8u(v[j][0], v[j][1]); }
        }
        float* sq = (float*)(ws + WS_SSQ1);
        for (int i = gt; i < 3 * M; i += NT) sq[i] = 0.f;
    }
}

__device__ __forceinline__ void conv_unit(const Args& a, int pm, int cs, int tid) {
    bf16* xbc = (bf16*)(a.ws + WS_XBC); const bf16* halo = (const bf16*)(a.ws + WS_HALO);
    const int cg8 = tid & 31, rseg = tid >> 5, col = cs * 256 + cg8 * 8, r0 = pm * 256 + rseg * 16;
    u32x4 raw[19];
#pragma unroll
    for (int i = 0; i < 3; ++i) {
        if (rseg > 0) raw[i] = *(const u32x4*)(xbc + (size_t)(r0 - 3 + i) * CD + col);
        else if ((pm & 31) != 0) raw[i] = *(const u32x4*)(halo + ((size_t)(pm - 1) * 3 + i) * CD + col);
        else raw[i] = (u32x4){0u, 0u, 0u, 0u};
    }
#pragma unroll
    for (int i = 0; i < 16; ++i) raw[3 + i] = *(const u32x4*)(xbc + (size_t)(r0 + i) * CD + col);
    f32x4 w[4][2], bv[2];
#pragma unroll
    for (int k = 0; k < 4; ++k) { w[k][0] = *(const f32x4*)(a.in[6] + k * CD + col); w[k][1] = *(const f32x4*)(a.in[6] + k * CD + col + 4); }
    bv[0] = *(const f32x4*)(a.in[7] + col); bv[1] = *(const f32x4*)(a.in[7] + col + 4);
    asm volatile("s_waitcnt vmcnt(0)" ::: "memory");
    __syncthreads();
#pragma unroll
    for (int i = 0; i < 16; ++i) {
        f32x4 acc0 = bv[0], acc1 = bv[1];
#pragma unroll
        for (int k = 0; k < 4; ++k) { const u32x4 u = raw[i + k];
            acc0 += w[k][0] * (f32x4){bflo(u.x), bfhi(u.x), bflo(u.y), bfhi(u.y)}; acc1 += w[k][1] * (f32x4){bflo(u.z), bfhi(u.z), bflo(u.w), bfhi(u.w)}; }
#pragma unroll
        for (int e = 0; e < 4; ++e) { acc0[e] = acc0[e] * sigm(acc0[e]); acc1[e] = acc1[e] * sigm(acc1[e]); }
        *(u32x4*)(xbc + (size_t)(r0 + i) * CD + col) = pack8u(acc0, acc1);
    }
}

__device__ __forceinline__ void acs_task(const Args& a, int task, int lane) {
    const float* dt = (const float*)(a.ws + WS_DT); float* acs = (float*)(a.ws + WS_ACS);
    const int cidx = task / NH, h = task % NH; const float av = -fexp(a.in[9][h]);
    const size_t r0 = (size_t)cidx * 128 + 2 * lane;
    const float v = dt[r0 * NH + h] * av, w = dt[(r0 + 1) * NH + h] * av;
    float s = v + w;
#pragma unroll
    for (int o = 1; o < 64; o <<= 1) { const float t = __shfl_up(s, o); if (lane >= o) s += t; }
    const float ex = s - (v + w);
    acs[r0 * NH + h] = ex + v; acs[(r0 + 1) * NH + h] = ex + v + w;
}

template <int DIL>
__device__ __forceinline__ void attn_pattern(const bf16* Kp, const bf16* Vp, size_t browbase, int hd, int T0, int r, int c, int g4,
                                             const bf16x8 (&qf)[2], const bf16x8 (&isel)[2], f32x4 (&o)[4], float& m_run, float& l_run) {
    constexpr int G = 16 / DIL, NT = DIL == 1 ? 12 : (DIL == 4 ? 6 : 5);
    const int rm = r % DIL, S0 = (T0 + r - rm) / DIL, s_lo = (S0 - 128) & ~7;
    const int sq = S0 + G * c;
    const int wlo = sq - 128 > 0 ? sq - 128 : 0; const unsigned wspan = (unsigned)(sq - wlo); const int kbase = s_lo + 8 * g4 - wlo;
    bf16x8 kb_[3][2][2], vb_[3][2][2];
    auto load_tile = [&](int tt, bf16x8 (&kk_)[2][2], bf16x8 (&vv_)[2][2]) {
#pragma unroll
        for (int hf = 0; hf < 2; ++hf) {
            int s = s_lo + 32 * tt + kkmap(c, hf); s = s < 0 ? 0 : s;
            int tok = s * DIL + rm; tok = tok > SEQ - 1 ? SEQ - 1 : tok;
            const size_t off = (browbase + tok) * AW + hd * 64 + 8 * g4;
#pragma unroll
            for (int ks = 0; ks < 2; ++ks) { kk_[hf][ks] = *(const bf16x8*)(Kp + off + 32 * ks); vv_[hf][ks] = *(const bf16x8*)(Vp + off + 32 * ks); }
        }
    };
    load_tile(0, kb_[0], vb_[0]); load_tile(1, kb_[1], vb_[1]);
#pragma unroll
    for (int tt = 0; tt < NT; ++tt) {
        if (tt + 2 < NT) load_tile(tt + 2, kb_[(tt + 2) % 3], vb_[(tt + 2) % 3]);
        const bf16x8 (&kf)[2][2] = kb_[tt % 3]; const bf16x8 (&vf)[2][2] = vb_[tt % 3];
        f32x4 sacc[2];
#pragma unroll
        for (int hf = 0; hf < 2; ++hf) { sacc[hf] = mfma16(kf[hf][0], qf[0], (f32x4){0.f, 0.f, 0.f, 0.f}); sacc[hf] = mfma16(kf[hf][1], qf[1], sacc[hf]); }
        float tmax = -INFINITY;
#pragma unroll
        for (int hf = 0; hf < 2; ++hf)
#pragma unroll
            for (int e = 0; e < 4; ++e) { const bool ok = (unsigned)(kbase + 32 * tt + 4 * hf + e) <= wspan;
                sacc[hf][e] = ok ? sacc[hf][e] : -INFINITY; tmax = fmaxf(tmax, sacc[hf][e]); }
        tmax = red_max_g4(tmax);
        if (__builtin_amdgcn_ballot_w64(tmax > m_run + 8.f) != 0ull) {
            const float m_new = fmaxf(m_run, tmax), m_u = (m_new == -INFINITY) ? 0.f : m_new, alpha = ex2(m_run - m_u);
            l_run *= alpha; m_run = m_new;
#pragma unroll
            for (int dvt = 0; dvt < 4; ++dvt) o[dvt] = o[dvt] * alpha;
        }
        const float m_use = (m_run == -INFINITY) ? 0.f : m_run;
        float ps = 0.f;
#pragma unroll
        for (int hf = 0; hf < 2; ++hf)
#pragma unroll
            for (int e = 0; e < 4; ++e) { sacc[hf][e] = ex2(sacc[hf][e] - m_use); ps += sacc[hf][e]; }
        l_run += ps;
        const bf16x8 pf = pack8(sacc[0], sacc[1]);
#pragma unroll
        for (int dvt = 0; dvt < 4; ++dvt) {
            const f32x4 z4 = {0.f, 0.f, 0.f, 0.f};
            const f32x4 t0 = mfma16(vf[0][dvt >> 1], isel[dvt & 1], z4), t1 = mfma16(vf[1][dvt >> 1], isel[dvt & 1], z4);
            o[dvt] = mfma16(pack8(t0, t1), pf, o[dvt]);
        }
    }
}

__device__ __forceinline__ void attn_tile(const bf16x8 (&kf)[2][2], const bf16x8 (&vt)[4], const bf16x8 (&qf)[2], const bf16x8 (&isel)[2], int s0, int sq, int g4,
                                          f32x4 (&o)[4], float& m_run, float& l_run) {
    const f32x4 z4 = {0.f, 0.f, 0.f, 0.f};
    f32x4 sacc[2];
#pragma unroll
    for (int hf = 0; hf < 2; ++hf) { sacc[hf] = mfma16(kf[hf][0], qf[0], z4); sacc[hf] = mfma16(kf[hf][1], qf[1], sacc[hf]); }
    const int wlo = sq - 128 > 0 ? sq - 128 : 0; const unsigned wspan = (unsigned)(sq - wlo); const int kbase = s0 + 8 * g4 - wlo;
    float tmax = -INFINITY;
#pragma unroll
    for (int hf = 0; hf < 2; ++hf)
#pragma unroll
        for (int e = 0; e < 4; ++e) { const bool ok = (unsigned)(kbase + 4 * hf + e) <= wspan;
            sacc[hf][e] = ok ? sacc[hf][e] : -INFINITY; tmax = fmaxf(tmax, sacc[hf][e]); }
    tmax = red_max_g4(tmax);
    if (__builtin_amdgcn_ballot_w64(tmax > m_run + 8.f) != 0ull) {
        const float m_new = fmaxf(m_run, tmax), m_u = (m_new == -INFINITY) ? 0.f : m_new, alpha = ex2(m_run - m_u);
        l_run *= alpha; m_run = m_new;
#pragma unroll
        for (int dvt = 0; dvt < 4; ++dvt) o[dvt] = o[dvt] * alpha;
    }
    const float m_use = (m_run == -INFINITY) ? 0.f : m_run;
    float ps = 0.f;
#pragma unroll
    for (int hf = 0; hf < 2; ++hf)
#pragma unroll
        for (int e = 0; e < 4; ++e) { sacc[hf][e] = ex2(sacc[hf][e] - m_use); ps += sacc[hf][e]; }
    l_run += ps;
    const bf16x8 pf = pack8(sacc[0], sacc[1]);
#pragma unroll
    for (int dvt = 0; dvt < 4; ++dvt) o[dvt] = mfma16(vt[dvt], pf, o[dvt]);
}
typedef short s16x4 __attribute__((ext_vector_type(4)));
template <int NT>
__device__ __forceinline__ void attn_lds_pattern(const LAS unsigned char* Kl, const LAS unsigned char* Vl, int ldsrow0, int s_lo, int sq, int c, int g4,
                                                 const bf16x8 (&qf)[2], const bf16x8 (&isel)[2], f32x4 (&o)[4], float& m_run, float& l_run) {
#pragma unroll 2
    for (int tt = 0; tt < NT; ++tt) {
        bf16x8 kf[2][2], vt[4];
#pragma unroll
        for (int hf = 0; hf < 2; ++hf) { const int off = (ldsrow0 + 32 * tt + kkmap(c, hf)) * 144 + 16 * g4;
#pragma unroll
            for (int ks = 0; ks < 2; ++ks) kf[hf][ks] = *(const LAS bf16x8*)(Kl + off + 64 * ks); }
        const LAS unsigned char* vb = Vl + (ldsrow0 + 32 * tt + 8 * g4 + (c >> 2)) * 144 + 8 * (c & 3);
#pragma unroll
        for (int dvt = 0; dvt < 4; ++dvt) {
            const s16x4 lo = __builtin_amdgcn_ds_read_tr16_b64_v4i16((LAS s16x4*)(vb + 32 * dvt)), hi = __builtin_amdgcn_ds_read_tr16_b64_v4i16((LAS s16x4*)(vb + 4 * 144 + 32 * dvt));
            vt[dvt] = __builtin_shufflevector(lo, hi, 0, 1, 2, 3, 4, 5, 6, 7);
        }
        attn_tile(kf, vt, qf, isel, s_lo + 32 * tt, sq, g4, o, m_run, l_run);
    }
}
constexpr int AL_V = 57600, AL_PT = 115200, AL_ML = AL_PT + 256 * 144;
__device__ __forceinline__ void attn_wg_unit(const Args& a, LAS unsigned char* lds, int b, int hd, int kb, int tid, int lane, int wave, const bf16x8 (&isel)[2]) {
    const bf16* Q = (const bf16*)(a.ws + WS_Q); const bf16* Kp = (const bf16*)(a.ws + WS_K); const bf16* Vp = (const bf16*)(a.ws + WS_V); bf16* mix = (bf16*)(a.ws + WS_MIX);
    const int c = lane & 15, g4 = lane >> 4, T0 = kb * 256; const size_t browbase = (size_t)b * SEQ;
    const int r1 = 4 * (wave >> 1) + (wave & 1), r2 = r1 + 2, tq1 = T0 + r1 + 16 * c, tq2 = T0 + r2 + 16 * c;
    LAS unsigned char* Kl = lds; LAS unsigned char* Vl = lds + AL_V;
    const size_t colb = (size_t)hd * 64;
    {
        u32x4 rk[7], rv[7];
#pragma unroll
        for (int i = 0; i < 7; ++i) { const int q = tid + 512 * i; if (q < 3200) { int tok = T0 - 128 + (q >> 3); tok = tok < 0 ? 0 : (tok > SEQ - 1 ? SEQ - 1 : tok);
            const size_t off = (browbase + tok) * AW + colb + (q & 7) * 8; rk[i] = *(const u32x4*)(Kp + off); rv[i] = *(const u32x4*)(Vp + off); } }
        __syncthreads();
#pragma unroll
        for (int i = 0; i < 7; ++i) { const int q = tid + 512 * i; if (q < 3200) { const int lo = (q >> 3) * 144 + (q & 7) * 16; *(LAS u32x4*)(Kl + lo) = rk[i]; *(LAS u32x4*)(Vl + lo) = rv[i]; } }
    }
    bf16x8 qf1[2], qf2[2];
    bf16x8 qcg[2][2];
#pragma unroll
    for (int gi = 0; gi < 2; ++gi)
#pragma unroll
        for (int ks = 0; ks < 2; ++ks) qcg[gi][ks] = *(const bf16x8*)(Q + (browbase + T0 + 16 * (wave + 8 * gi) + c) * AW + colb + 32 * ks + 8 * g4);
    f32x4 o1[4], o2[4];
#pragma unroll
    for (int i = 0; i < 4; ++i) { o1[i] = (f32x4){0.f, 0.f, 0.f, 0.f}; o2[i] = (f32x4){0.f, 0.f, 0.f, 0.f}; }
    float m1 = -INFINITY, l1 = 0.f, m2 = -INFINITY, l2 = 0.f;
    __syncthreads();
    u32x4 bk[6], bv[6];
    auto load_b = [&](int cl0) {
#pragma unroll
        for (int i = 0; i < 6; ++i) { const int q = tid + 512 * i, j = q >> 3, ci = j >= 192 ? 1 : 0, jj = j - 192 * ci; int tok = (T0 / 4 - 128 + jj) * 4 + cl0 + ci; tok = tok < 0 ? 0 : (tok > SEQ - 1 ? SEQ - 1 : tok);
            const size_t off = (browbase + tok) * AW + colb + (q & 7) * 8; bk[i] = *(const u32x4*)(Kp + off); bv[i] = *(const u32x4*)(Vp + off); }
    };
    auto store_b = [&]() {
#pragma unroll
        for (int i = 0; i < 6; ++i) { const int q = tid + 512 * i; const int lo = (q >> 3) * 144 + (q & 7) * 16; *(LAS u32x4*)(Kl + lo) = bk[i]; *(LAS u32x4*)(Vl + lo) = bv[i]; }
    };
#pragma unroll
    for (int gi = 0; gi < 2; ++gi) {
        const int gq = wave + 8 * gi, tqc = T0 + 16 * gq + c;
        if (gi == 1) {
#pragma unroll
            for (int ks = 0; ks < 2; ++ks) { qf1[ks] = *(const bf16x8*)(Q + (browbase + tq1) * AW + colb + 32 * ks + 8 * g4); qf2[ks] = *(const bf16x8*)(Q + (browbase + tq2) * AW + colb + 32 * ks + 8 * g4); }
            load_b(0);
        }
        const bf16x8 (&qc)[2] = qcg[gi];
        f32x4 oc[4];
#pragma unroll
        for (int i = 0; i < 4; ++i) oc[i] = (f32x4){0.f, 0.f, 0.f, 0.f};
        float mc = -INFINITY, lc = 0.f;
        attn_lds_pattern<5>(Kl, Vl, 16 * gq, T0 + 16 * gq - 128, tqc, c, g4, qc, isel, oc, mc, lc);
        lc = red_sum_g4(lc);
        int cx = c, gx = g4; asm volatile("" : "+v"(cx), "+v"(gx));
        LAS unsigned char* pr = lds + AL_PT + (16 * gq + cx) * 144 + 8 * gx;
#pragma unroll
        for (int dvt = 0; dvt < 4; ++dvt) { u32x2 ov; ov.x = pk(oc[dvt][0], oc[dvt][1]); ov.y = pk(oc[dvt][2], oc[dvt][3]); *(LAS u32x2*)(pr + 32 * dvt) = ov; }
        if (gx == 0) { LAS float* ml = (LAS float*)(lds + AL_ML) + 2 * (16 * gq + cx); ml[0] = mc; ml[1] = lc; }
    }
    __syncthreads(); store_b(); __syncthreads();
    {
        int cx = c, gx = g4; asm volatile("" : "+v"(cx), "+v"(gx));
        const LAS unsigned char* p1 = lds + AL_PT + (r1 + 16 * cx) * 144 + 8 * gx; const LAS unsigned char* p2 = lds + AL_PT + (r2 + 16 * cx) * 144 + 8 * gx;
#pragma unroll
        for (int dvt = 0; dvt < 4; ++dvt) { const u32x2 w1 = *(const LAS u32x2*)(p1 + 32 * dvt), w2 = *(const LAS u32x2*)(p2 + 32 * dvt);
            o1[dvt] = (f32x4){bflo(w1.x), bfhi(w1.x), bflo(w1.y), bfhi(w1.y)}; o2[dvt] = (f32x4){bflo(w2.x), bfhi(w2.x), bflo(w2.y), bfhi(w2.y)}; }
        const LAS float* ml1 = (const LAS float*)(lds + AL_ML) + 2 * (r1 + 16 * cx); const LAS float* ml2 = (const LAS float*)(lds + AL_ML) + 2 * (r2 + 16 * cx);
        m1 = ml1[0]; l1 = (gx == 0) ? ml1[1] : 0.f; m2 = ml2[0]; l2 = (gx == 0) ? ml2[1] : 0.f;
    }
    load_b(2);
    attn_lds_pattern<6>(Kl, Vl, 192 * (wave & 1), T0 / 4 - 128, T0 / 4 + (r1 >> 2) + 4 * c, c, g4, qf1, isel, o1, m1, l1);
    __syncthreads(); store_b(); __syncthreads();
    attn_lds_pattern<6>(Kl, Vl, 192 * (wave & 1), T0 / 4 - 128, T0 / 4 + (r2 >> 2) + 4 * c, c, g4, qf2, isel, o2, m2, l2);
    attn_pattern<16>(Kp, Vp, browbase, hd, T0, r1, c, g4, qf1, isel, o1, m1, l1);
    attn_pattern<16>(Kp, Vp, browbase, hd, T0, r2, c, g4, qf2, isel, o2, m2, l2);
    {
        float l = l1; l = red_sum_g4(l); const float inv = 1.f / l;
        bf16* orow = mix + (browbase + tq1) * MIXW + SW + colb + 4 * g4;
#pragma unroll
        for (int dvt = 0; dvt < 4; ++dvt) { const f32x4 w = o1[dvt] * inv; u32x2 ov; ov.x = pk(w[0], w[1]); ov.y = pk(w[2], w[3]); *(u32x2*)(orow + 16 * dvt) = ov; }
    }
    {
        float l = l2; l = red_sum_g4(l); const float inv = 1.f / l;
        bf16* orow = mix + (browbase + tq2) * MIXW + SW + colb + 4 * g4;
#pragma unroll
        for (int dvt = 0; dvt < 4; ++dvt) { const f32x4 w = o2[dvt] * inv; u32x2 ov; ov.x = pk(w[0], w[1]); ov.y = pk(w[2], w[3]); *(u32x2*)(orow + 16 * dvt) = ov; }
    }
}

constexpr int YL_ACS = 0, YL_DT = 6144, YL_B = 12288, YL_X = YL_B + 128 * 272, YL_P = YL_X + 2 * 128 * 144, YL_END = YL_P + 2 * 64 * 272;
constexpr int YL_DSK = YL_END;
static_assert(YL_DSK + 64 <= 131072, "SSD LDS map");
__device__ __forceinline__ void ssd_load_x(const bf16* xbc, size_t rowbase, int h, int tid, u32x4 (&r)[2]) {
#pragma unroll
    for (int i = 0; i < 2; ++i) { const int q = tid + 512 * i; r[i] = *(const u32x4*)(xbc + (rowbase + (q >> 3)) * CD + h * 64 + (q & 7) * 8); }
}
__device__ __forceinline__ void ssd_store_x(LAS unsigned char* X, int tid, const u32x4 (&r)[2]) {
#pragma unroll
    for (int i = 0; i < 2; ++i) { const int q = tid + 512 * i; *(LAS u32x4*)(X + (q >> 3) * 144 + (q & 7) * 16) = r[i]; }
}
__device__ __forceinline__ void ssd_load_p(const bf16* Sh, int tid, u32x4 (&r)[2]) {
#pragma unroll
    for (int i = 0; i < 2; ++i) { const int q = tid + 512 * i; r[i] = *(const u32x4*)(Sh + (q >> 4) * 128 + (q & 15) * 8); }
}
__device__ __forceinline__ void ssd_store_p(LAS unsigned char* P, int tid, const u32x4 (&r)[2]) {
#pragma unroll
    for (int i = 0; i < 2; ++i) { const int q = tid + 512 * i; *(LAS u32x4*)(P + (q >> 4) * 272 + (q & 15) * 16) = r[i]; }
}
__device__ __forceinline__ void ssd_stage_common(const Args& a, LAS unsigned char* lds, size_t rowbase, int g, int tid) {
    const bf16* xbc = (const bf16*)(a.ws + WS_XBC); const float* dt = (const float*)(a.ws + WS_DT); const float* acs = (const float*)(a.ws + WS_ACS);
    u32x4 rb[4];
#pragma unroll
    for (int i = 0; i < 4; ++i) { const int q = tid + 512 * i; rb[i] = *(const u32x4*)(xbc + (rowbase + (q >> 4)) * CD + SW + g * 128 + (q & 15) * 8); }
    LAS float* acsL = (LAS float*)(lds + YL_ACS); LAS float* dtL = (LAS float*)(lds + YL_DT);
#pragma unroll
    for (int k = 0; k < 3; ++k) { const int idx = tid + 512 * k, hh = idx >> 7, sidx = idx & 127; const size_t gi = (rowbase + sidx) * NH + 12 * g + hh; acsL[idx] = acs[gi]; dtL[idx] = dt[gi]; }
#pragma unroll
    for (int i = 0; i < 4; ++i) { const int q = tid + 512 * i; *(LAS u32x4*)(lds + YL_B + (q >> 4) * 272 + (q & 15) * 16) = rb[i]; }
    if (tid < 12) ((LAS float*)(lds + YL_DSK))[tid] = a.in[10][12 * g + tid];
}

__device__ __forceinline__ void states_unit(const Args& a, LAS unsigned char* lds, int u, int tid, int lane, int wave, const bf16x8 (&isel)[2]) {
    const bf16* xbc = (const bf16*)(a.ws + WS_XBC); bf16* S = (bf16*)a.out;
    const int g = u & 1, bc = u >> 1; const size_t rowbase = (size_t)bc * 128;
    const LAS float* acsL = (const LAS float*)(lds + YL_ACS); const LAS float* dtL = (const LAS float*)(lds + YL_DT);
    const int c = lane & 15, g4 = lane >> 4, pt = wave >> 1, nh = wave & 1;
    const f32x4 z4 = {0.f, 0.f, 0.f, 0.f};
    {
        u32x4 rx[2]; ssd_load_x(xbc, rowbase, 12 * g, tid, rx);
        ssd_stage_common(a, lds, rowbase, g, tid);
        ssd_store_x(lds + YL_X, tid, rx);
    }
    __syncthreads();
    bf16x8 iselp;
#pragma unroll
    for (int j = 0; j < 8; ++j) iselp[j] = (8 * g4 + j == 16 * (pt & 1) + c) ? (short)0x3F80 : (short)0;
    bf16x8 bmT[4][4];
#pragma unroll
    for (int kt = 0; kt < 4; ++kt)
#pragma unroll
        for (int nt = 0; nt < 4; ++nt) {
            f32x4 bm[2];
#pragma unroll
            for (int hf = 0; hf < 2; ++hf) bm[hf] = mfma16(*(const LAS bf16x8*)(lds + YL_B + (32 * kt + kkmap(c, hf)) * 272 + (64 * nh + 32 * (nt >> 1) + 8 * g4) * 2), isel[nt & 1], z4);
            bmT[kt][nt] = pack8(bm[0], bm[1]);
        }
    u32x4 rxa[2], rxb[2];
    ssd_load_x(xbc, rowbase, 12 * g + 1, tid, rxb);
    auto head = [&](int hh, u32x4 (&rx_load)[2], const u32x4 (&rx_store)[2]) {
        const int h = 12 * g + hh;
        if (hh + 2 < 12) ssd_load_x(xbc, rowbase, h + 2, tid, rx_load);
        const LAS unsigned char* X = lds + YL_X + (hh & 1) * (128 * 144);
        const float acs_last = acsL[hh * 128 + 127];
        f32x4 acc[4] = {z4, z4, z4, z4};
#pragma unroll
        for (int kt = 0; kt < 4; ++kt) {
            f32x4 t[2];
#pragma unroll
            for (int hf = 0; hf < 2; ++hf) {
                const f32x4 as4 = *(const LAS f32x4*)(acsL + hh * 128 + 32 * kt + 8 * g4 + 4 * hf), dt4 = *(const LAS f32x4*)(dtL + hh * 128 + 32 * kt + 8 * g4 + 4 * hf);
                f32x4 scl;
#pragma unroll
                for (int e = 0; e < 4; ++e) scl[e] = dt4[e] * fexp(acs_last - as4[e]);
                t[hf] = mfma16(*(const LAS bf16x8*)(X + (32 * kt + kkmap(c, hf)) * 144 + (32 * (pt >> 1) + 8 * g4) * 2), iselp, z4) * scl;
            }
            const bf16x8 xT = pack8(t[0], t[1]);
#pragma unroll
            for (int nt = 0; nt < 4; ++nt) acc[nt] = mfma16(bmT[kt][nt], xT, acc[nt]);
        }
        bf16* sp = S + ((size_t)bc * NH + h) * 8192 + (size_t)(16 * pt + c) * 128 + 64 * nh + 4 * g4;
#pragma unroll
        for (int nt = 0; nt < 4; ++nt) { u32x2 ov; ov.x = pk(acc[nt][0], acc[nt][1]); ov.y = pk(acc[nt][2], acc[nt][3]); *(u32x2*)(sp + 16 * nt) = ov; }
        if (hh + 1 < 12) ssd_store_x(lds + YL_X + ((hh + 1) & 1) * (128 * 144), tid, rx_store);
        __syncthreads();
    };
#pragma unroll 1
    for (int hh = 0; hh < 12; hh += 2) { head(hh, rxa, rxb); head(hh + 1, rxb, rxa); }
}

__device__ __forceinline__ void scan_phase(const Args& a, int tid, int G) {
    const float* acs = (const float*)(a.ws + WS_ACS); bf16* S = (bf16*)a.out;
    const int NT = G * 512;
    for (int e = blockIdx.x * 512 + tid; e < 8 * NH * 64 * 32; e += NT) {
        const int n4 = e & 31, p = (e >> 5) & 63, h = (e >> 11) % NH, b = e / (2048 * NH);
        u32x2* base = (u32x2*)(S + ((size_t)(b * 64) * NH + h) * 8192 + p * 128 + 4 * n4);
        const float* ap = acs + ((size_t)b * SEQ + 127) * NH + h;
        f32x4 carry = {0.f, 0.f, 0.f, 0.f};
        u32x2 sv[2][8]; float dc[2][8];
#pragma unroll
        for (int j = 0; j < 8; ++j) { sv[0][j] = base[(size_t)j * NH * 2048]; dc[0][j] = ap[(size_t)j * 128 * NH]; }
#pragma unroll
        for (int cb = 0; cb < 8; ++cb) {
            if (cb + 1 < 8) {
#pragma unroll
                for (int j = 0; j < 8; ++j) { sv[(cb + 1) & 1][j] = base[(size_t)((cb + 1) * 8 + j) * NH * 2048]; dc[(cb + 1) & 1][j] = ap[(size_t)((cb + 1) * 8 + j) * 128 * NH]; }
            }
#pragma unroll
            for (int j = 0; j < 8; ++j) {
                const u32x2 w = sv[cb & 1][j];
                u32x2 ov; ov.x = pk(carry[0], carry[1]); ov.y = pk(carry[2], carry[3]); base[(size_t)(cb * 8 + j) * NH * 2048] = ov;
                carry = carry * fexp(dc[cb & 1][j]) + (f32x4){bflo(w.x), bfhi(w.x), bflo(w.y), bfhi(w.y)};
            }
        }
    }
}

__device__ __forceinline__ void y_unit(const Args& a, LAS unsigned char* lds, int u, int tid, int lane, int wave, const bf16x8 (&isel)[2]) {
    const bf16* xbc = (const bf16*)(a.ws + WS_XBC); const bf16* zb = (const bf16*)(a.ws + WS_Z);
    const bf16* S = (const bf16*)a.out; bf16* mix = (bf16*)(a.ws + WS_MIX);
    const int g = u & 1, bc = u >> 1; const size_t rowbase = (size_t)bc * 128;
    const LAS float* acsL = (const LAS float*)(lds + YL_ACS); const LAS float* dtL = (const LAS float*)(lds + YL_DT);
    const int lb = (wave < 4) ? wave : 11 - wave;
    const int c = lane & 15, g4 = lane >> 4, l = 16 * lb + c, ktmax = lb >> 1; const size_t myrow = rowbase + l;
    const f32x4 z4 = {0.f, 0.f, 0.f, 0.f};
    {
        u32x4 rx[2], rp[2]; ssd_load_x(xbc, rowbase, 12 * g, tid, rx); ssd_load_p(S + ((size_t)bc * NH + 12 * g) * 8192, tid, rp);
        ssd_stage_common(a, lds, rowbase, g, tid);
        ssd_store_x(lds + YL_X, tid, rx); ssd_store_p(lds + YL_P, tid, rp);
    }
    bf16x8 cf[4];
#pragma unroll
    for (int ks = 0; ks < 4; ++ks) cf[ks] = *(const bf16x8*)(xbc + myrow * CD + SW + 256 + g * 128 + 32 * ks + 8 * g4);
    __syncthreads();
    f32x4 cbt[4][2];
#pragma unroll
    for (int kt = 0; kt < 4; ++kt)
#pragma unroll
        for (int hf = 0; hf < 2; ++hf) {
            cbt[kt][hf] = z4;
            if (kt <= ktmax) {
                const LAS unsigned char* rp = lds + YL_B + (32 * kt + kkmap(c, hf)) * 272 + 16 * g4;
#pragma unroll
                for (int ks = 0; ks < 4; ++ks) cbt[kt][hf] = mfma16(*(const LAS bf16x8*)(rp + 64 * ks), cf[ks], cbt[kt][hf]);
            }
        }
    float ssq = 0.f;
    u32x4 rxa[2], rpa[2]; u32x2 xza[4];
#pragma unroll
    for (int pt = 0; pt < 4; ++pt) { const int pcol = (12 * g) * 64 + 16 * pt + 4 * g4; xza[pt] = *(const u32x2*)(zb + myrow * SW + pcol); }
    auto head = [&](int hh) {
        const int h = 12 * g + hh; const float acs_l = acsL[hh * 128 + l];
        if (hh + 1 < 12) { ssd_load_x(xbc, rowbase, h + 1, tid, rxa); ssd_load_p(S + ((size_t)bc * NH + h + 1) * 8192, tid, rpa); }
        const LAS unsigned char* X = lds + YL_X + (hh & 1) * (128 * 144); const LAS unsigned char* P = lds + YL_P + (hh & 1) * (64 * 272);
        f32x4 yT[4] = {z4, z4, z4, z4};
#pragma unroll
        for (int kt = 0; kt < 4; ++kt) {
            if (kt <= ktmax) {
                f32x4 gt[2]; bf16x8 xf[2][2];
#pragma unroll
                for (int hf = 0; hf < 2; ++hf) {
                    const f32x4 as4 = *(const LAS f32x4*)(acsL + hh * 128 + 32 * kt + 8 * g4 + 4 * hf), dt4 = *(const LAS f32x4*)(dtL + hh * 128 + 32 * kt + 8 * g4 + 4 * hf);
#pragma unroll
                    for (int e = 0; e < 4; ++e) { const int sidx = 32 * kt + 8 * g4 + 4 * hf + e; gt[hf][e] = (sidx <= l) ? cbt[kt][hf][e] * dt4[e] * fexp(fminf(acs_l - as4[e], 0.f)) : 0.f; }
                    const LAS unsigned char* xr = X + (32 * kt + kkmap(c, hf)) * 144 + 16 * g4;
                    xf[hf][0] = *(const LAS bf16x8*)xr; xf[hf][1] = *(const LAS bf16x8*)(xr + 64);
                }
                const bf16x8 gT = pack8(gt[0], gt[1]);
#pragma unroll
                for (int pt = 0; pt < 4; ++pt) {
                    const f32x4 t0 = mfma16(xf[0][pt >> 1], isel[pt & 1], z4), t1 = mfma16(xf[1][pt >> 1], isel[pt & 1], z4);
                    yT[pt] = mfma16(pack8(t0, t1), gT, yT[pt]);
                }
            }
        }
        const float el = fexp(acs_l), dsk = ((const LAS float*)(lds + YL_DSK))[hh];
#pragma unroll
        for (int pt = 0; pt < 4; ++pt) {
            f32x4 yo = z4;
#pragma unroll
            for (int ks = 0; ks < 4; ++ks) yo = mfma16(*(const LAS bf16x8*)(P + (16 * pt + c) * 272 + 64 * ks + 16 * g4), cf[ks], yo);
            const int pcol = h * 64 + 16 * pt + 4 * g4;
            const u32x2 xw = *(const LAS u32x2*)(X + l * 144 + (16 * pt + 4 * g4) * 2), zw = xza[pt];
            const f32x4 xv = {bflo(xw.x), bfhi(xw.x), bflo(xw.y), bfhi(xw.y)}, zv = {bflo(zw.x), bfhi(zw.x), bflo(zw.y), bfhi(zw.y)};
            f32x4 uo;
#pragma unroll
            for (int e = 0; e < 4; ++e) { const float yv = yT[pt][e] + el * yo[e] + dsk * xv[e]; uo[e] = yv * zv[e] * sigm(zv[e]); ssq += uo[e] * uo[e]; }
            u32x2 ov; ov.x = pk(uo[0], uo[1]); ov.y = pk(uo[2], uo[3]);
            *(u32x2*)(mix + myrow * MIXW + pcol) = ov;
        }
        if (hh + 1 < 12) {
#pragma unroll
            for (int pt = 0; pt < 4; ++pt) { const int pcol = (h + 1) * 64 + 16 * pt + 4 * g4; xza[pt] = *(const u32x2*)(zb + myrow * SW + pcol); }
            ssd_store_x(lds + YL_X + ((hh + 1) & 1) * (128 * 144), tid, rxa); ssd_store_p(lds + YL_P + ((hh + 1) & 1) * (64 * 272), tid, rpa);
        }
        __syncthreads();
    };
#pragma unroll 1
    for (int hh = 0; hh < 12; ++hh) head(hh);
    ssq = red_sum_g4(ssq);
    const float rs = rsqrtf(ssq * (1.f / 768.f) + EPS);
    if (g4 == 0) ((float*)(a.ws + WS_RS))[2 * myrow + g] = rs;
}

#define RLX_AGENT __ATOMIC_RELAXED, __HIP_MEMORY_SCOPE_AGENT
#define XB_TMO      128
#define XB_XCNT(j)  (256  + 64 * (j))
#define XB_XSUB(j)  (1280 + 64 * (j))
#define XB_XGEN(j)  (2304 + 64 * (j))
#define XB_TOP      3328
#define XB_TOPGEN   3392
#define XCD_BAR_WORDS 3456
#define XB_SPIN_CAP (1u << 18)

__device__ __forceinline__ unsigned xb_ld(unsigned* p)              { return __hip_atomic_load(p, __ATOMIC_RELAXED, __HIP_MEMORY_SCOPE_AGENT); }
__device__ __forceinline__ unsigned xb_add(unsigned* p, unsigned v) { return __hip_atomic_fetch_add(p, v, __ATOMIC_RELAXED, __HIP_MEMORY_SCOPE_AGENT); }
__device__ __forceinline__ unsigned xb_xcc_id() { return (unsigned)__builtin_amdgcn_s_getreg((3 << 11) | 20) & 0xFu; }
#define XB_SPIN(cond, bar) do { unsigned _sp = 0; while (cond) { __builtin_amdgcn_s_sleep(1); \
    if ((++_sp & 255u) == 0u) { if (xb_ld(&(bar)[XB_TMO])) break; if (_sp > XB_SPIN_CAP) { atomicAdd(&(bar)[XB_TMO], 1u); break; } } } } while (0)

struct XcdBarrier {
    unsigned* bar; unsigned x;
    volatile LAS unsigned* st;
};

__device__ __forceinline__ XcdBarrier xcd_barrier_post(unsigned* bar, volatile LAS unsigned* st) {
    XcdBarrier b; b.bar = bar; b.x = xb_xcc_id(); b.st = st;
    if (threadIdx.x == 0) (void)xb_add(&bar[XB_XCNT(b.x)], 1u);
    return b;
}
__device__ __forceinline__ void xcd_barrier_complete(unsigned* bar, unsigned x, unsigned& nloc, unsigned& nx) {
    const unsigned G = gridDim.x * gridDim.y * gridDim.z;
    unsigned sum, cnt, mine, sp = 0u;
    for (;;) {
        sum = 0u; cnt = 0u; mine = 0u;
#pragma unroll
        for (unsigned j = 0; j < 16; ++j) { const unsigned c = xb_ld(&bar[XB_XCNT(j)]); sum += c; cnt += (c > 0u) ? 1u : 0u; mine = (j == x) ? c : mine; }
        if (sum == G) break;
        __builtin_amdgcn_s_sleep(1);
        if ((++sp & 255u) == 0u) { if (xb_ld(&bar[XB_TMO])) break; if (sp > XB_SPIN_CAP) { atomicAdd(&bar[XB_TMO], 1u); break; } }
    }
    nloc = mine > 0u ? mine : 1u; nx = cnt > 0u ? cnt : 1u;
}

__device__ __forceinline__ void xcd_barrier(const XcdBarrier& b, const bool leader) {
    asm volatile("s_waitcnt vmcnt(0)" ::: "memory");
    __syncthreads();
    if (leader) {
        unsigned* bar = b.bar;
        __builtin_amdgcn_s_waitcnt(0);
        unsigned nloc = b.st[0], nx = b.st[1];
        if (nloc == 0u) { xcd_barrier_complete(bar, b.x, nloc, nx); b.st[0] = nloc; b.st[1] = nx; }
        const unsigned old = xb_add(&bar[XB_XSUB(b.x)], 1u);
        const unsigned gen = old / nloc;
        if (old + 1u == (gen + 1u) * nloc) {
            __builtin_amdgcn_fence(__ATOMIC_RELEASE, "agent");
            asm volatile("s_waitcnt vmcnt(0)" ::: "memory");
            const unsigned og = xb_add(&bar[XB_TOP], 1u);
            const unsigned tg = og / nx;
            if (og + 1u == (tg + 1u) * nx) xb_add(&bar[XB_TOPGEN], 1u);
            else XB_SPIN(xb_ld(&bar[XB_TOPGEN]) == tg, bar);
            __builtin_amdgcn_fence(__ATOMIC_ACQUIRE, "agent");
            xb_add(&bar[XB_XGEN(b.x)], 1u);
            asm volatile("s_waitcnt vmcnt(0)" ::: "memory");
        } else {
            XB_SPIN(xb_ld(&bar[XB_XGEN(b.x)]) == gen, bar);
            __builtin_amdgcn_fence(__ATOMIC_ACQUIRE, "agent");
            asm volatile("s_waitcnt vmcnt(0)" ::: "memory");
        }
    }
    __syncthreads();
}


constexpr size_t WS_BAR = 768 * 1024;
constexpr int LDS_MISC = 155648;
constexpr int LDS_BYTES = 163840;
__global__ void __launch_bounds__(512, 2) hymba_fwd(Args a) {
    __builtin_assume(__builtin_amdgcn_workitem_id_y() == 0); __builtin_assume(__builtin_amdgcn_workitem_id_z() == 0);
    extern __shared__ __attribute__((aligned(16))) unsigned char lds_raw[];
    LAS unsigned char* lds = (LAS unsigned char*)lds_raw;
    cg::grid_group grid = cg::this_grid();
    const int wave = __builtin_amdgcn_readfirstlane((int)threadIdx.x >> 6), G = gridDim.x;
#define TID_LANE int lane; asm volatile("v_mbcnt_lo_u32_b32 %0, -1, 0\n\tv_mbcnt_hi_u32_b32 %0, -1, %0" : "=v"(lane)); const int tid = wave * 64 + lane; (void)tid;
    unsigned char* ws = a.ws;
    const int lo = a.ph_lo, hi = a.ph_hi;
#define IN(k) (lo <= (k) && (k) < hi)
#if MK_N_LAUNCHES == 1
    volatile LAS unsigned* misc = (volatile LAS unsigned*)(lds + LDS_MISC);
    if (threadIdx.x < 2) misc[threadIdx.x] = 0u;
    __syncthreads();
    XcdBarrier bar = xcd_barrier_post((unsigned*)(ws + WS_BAR), misc);
#define SEAM(k) do { if (IN(k) && IN((k) + 1)) { int l_; asm volatile("v_mbcnt_lo_u32_b32 %0, -1, 0\n\tv_mbcnt_hi_u32_b32 %0, -1, %0" : "=v"(l_)); xcd_barrier(bar, wave == 0 && l_ == 0); } } while (0)
    if (hi > NPH) grid.sync();
#else
#define SEAM(k) do { } while (0)
#endif
    if (IN(0)) { TID_LANE p0_prologue(a, lds, tid, lane, wave, G); }
#ifdef PROBE_P0
    if (IN(0)) { TID_LANE p0_prologue(a, lds, tid, lane, wave, G); }
#endif
    SEAM(0);
    if (IN(1)) {
        pg8::Gemm g{(const bf16*)a.out, (const bf16*)(ws + WS_WIN), M, NP, D}; pg8::StaticOrder S; S.init(M, NP, G, (int)blockIdx.x);
        EpiInProj E{ws, a.in[4], a.in[5], a.in[8]};
        pg8::gemm_phase<EpiInProj, pg8::StaticOrder, true, true>(lds, g, S, E, wave);
    }
    SEAM(1);
    if (IN(2)) {
        TID_LANE
        for (int u = blockIdx.x; u < 256 * 8; u += G) conv_unit(a, u >> 3, u & 7, tid);
        for (int t = blockIdx.x * 8 + wave; t < 512 * NH; t += G * 8) acs_task(a, t, lane);
        bf16x8 isel[2]; make_isel(lane, isel);
#ifdef PROBE_ATT
        for (int rep = 0; rep < 2; ++rep)
#endif
        for (int u0 = blockIdx.x; u0 < 64 * 32; u0 += G) {
            int u = u0; if ((G & 7) == 0) { const int x = u0 & 7, v = u0 >> 3; u = ((v >> 5) * 8 + x) * 32 + (v & 31); }
            const int kb = u & 31, bh = u >> 5;
            attn_wg_unit(a, lds, bh >> 3, bh & 7, kb, tid, lane, wave, isel);
        }
    }
    SEAM(2);
    if (IN(3)) { TID_LANE bf16x8 isel[2]; make_isel(lane, isel);
#if defined(PROBE_SSD) || defined(PROBE_P3)
      for (int rep = 0; rep < 2; ++rep)
#endif
      for (int u0 = blockIdx.x; u0 < 1024; u0 += G) { int u = u0; if ((G & 7) == 0) { const int x = u0 & 7, v = u0 >> 3; u = x * 128 + v; }
          states_unit(a, lds, u, tid, lane, wave, isel); } }
    SEAM(3);
    if (IN(4)) { TID_LANE scan_phase(a, tid, G); }
    SEAM(4);
    if (IN(5)) { TID_LANE bf16x8 isel[2]; make_isel(lane, isel);
#ifdef PROBE_SSD
      for (int rep = 0; rep < 2; ++rep)
#endif
      for (int u0 = blockIdx.x; u0 < 1024; u0 += G) { int u = u0; if ((G & 7) == 0) { const int x = u0 & 7, v = u0 >> 3; u = x * 128 + v; }
          y_unit(a, lds, u, tid, lane, wave, isel); } }
    SEAM(5);
    if (IN(6)) {
        pg8::Gemm g{(const bf16*)(ws + WS_MIX), (const bf16*)(ws + WS_WOUT), M, D, MIXW}; pg8::StaticOrder S; S.init(M, D, G, (int)blockIdx.x);
        EpiResNorm<true> E{a.in[0], a.out, (bf16*)(ws + WS_XB), a.in[13], (float*)(ws + WS_SSQ1), (const float*)(ws + WS_RS)};
        pg8::gemm_phase<EpiResNorm<true>, pg8::StaticOrder, true, true>(lds, g, S, E, wave);
    }
    SEAM(6);
    if (IN(7)) {
        pg8::Gemm g{(const bf16*)(ws + WS_XB), (const bf16*)(ws + WS_WGU), M, 2 * FF, D}; pg8::StaticOrder S; S.init(M, 2 * FF, G, (int)blockIdx.x);
        EpiSwiGLU E{(const float*)(ws + WS_SSQ1), (bf16*)(ws + WS_HMID)};
        pg8::gemm_phase<EpiSwiGLU, pg8::StaticOrder, true, true>(lds, g, S, E, wave);
#ifdef PROBE_G3
        pg8::gemm_phase<EpiSwiGLU, pg8::StaticOrder, true, true>(lds, g, S, E, wave);
#endif
    }
    SEAM(7);
    if (IN(8)) {
        { pg8::Gemm g{(const bf16*)(ws + WS_HMID), (const bf16*)(ws + WS_WDN), M, D, FF}; pg8::StaticOrder S; S.init(M, D, G, (int)blockIdx.x);
          EpiResNorm<false> E{a.out, a.out, (bf16*)(ws + WS_XB), a.in[17], (float*)(ws + WS_SSQ2), nullptr};
          pg8::gemm_phase<EpiResNorm<false>, pg8::StaticOrder, true, true>(lds, g, S, E, wave); }
        { pg8::Gemm g{(const bf16*)(ws + WS_PB), (const bf16*)(ws + WS_WPLE), M, D, PD}; pg8::StaticOrder S; S.init(M, D, G, (int)blockIdx.x);
          EpiPle E{(bf16*)(ws + WS_T), (float*)(ws + WS_SSQT)};
          pg8::gemm_phase<EpiPle, pg8::StaticOrder, true, true>(lds, g, S, E, wave); }
    }
    SEAM(8);
    if (IN(9)) {
        pg8::Gemm g{(const bf16*)(ws + WS_XB), (const bf16*)(ws + WS_WPG), M, D, D}; pg8::StaticOrder S; S.init(M, D, G, (int)blockIdx.x);
        EpiFinal E{a.out, (const bf16*)(ws + WS_T), (const float*)(ws + WS_SSQ2), (const float*)(ws + WS_SSQT), a.in[19], a.in[21]};
        pg8::gemm_phase<EpiFinal, pg8::StaticOrder, true, true>(lds, g, S, E, wave);
    }
#undef IN
#undef SEAM
}

#ifdef DBG_STOP
__global__ void dbg_dump(const unsigned* src, float* out, size_t n) {
    for (size_t i = (size_t)blockIdx.x * blockDim.x + threadIdx.x; i < n; i += (size_t)gridDim.x * blockDim.x) {
#ifdef DBG_ATT
        if (i < (size_t)M * 256) { const unsigned u = src[(i >> 8) * 1024 + (i & 255)]; out[i] = bflo(u) + 2.f * bfhi(u); } else out[i] = 0.f;
#else
        const unsigned u = src[i]; out[i] = bflo(u) + 2.f * bfhi(u);
#endif
    }
}
#endif
extern "C" void kernel_launch(void* const* d_in, const int* in_sizes, int n_in, void* d_out, int out_size, void* d_ws, size_t ws_size, hipStream_t stream) {
    static int grid = 0;
    if (grid == 0) {
        int dev = 0, cus = 0, per_cu = 0;
        if (n_in != 22 || ws_size < WS_END) { fprintf(stderr, "kernel_launch: unexpected n_in %d / ws %zu\n", n_in, ws_size); grid = -1; return; }
        hipGetDevice(&dev); hipDeviceGetAttribute(&cus, hipDeviceAttributeMultiprocessorCount, dev);
        if (hipFuncSetAttribute((const void*)hymba_fwd, hipFuncAttributeMaxDynamicSharedMemorySize, LDS_BYTES) != hipSuccess) { fprintf(stderr, "kernel_launch: hipFuncSetAttribute failed\n"); grid = -1; return; }
        if (hipOccupancyMaxActiveBlocksPerMultiprocessor(&per_cu, (const void*)hymba_fwd, 512, LDS_BYTES) != hipSuccess || per_cu < 1) { fprintf(stderr, "kernel_launch: occupancy query says %d\n", per_cu); per_cu = 1; }
        (void)hipGetLastError();
        grid = cus * per_cu;
    }
    if (grid < 0) return;
    if (hipMemsetAsync((char*)d_ws + WS_BAR, 0, 16384, stream) != hipSuccess) { fprintf(stderr, "kernel_launch: memset of barrier words failed\n"); return; }
    Args a{};
    for (int i = 0; i < 22; ++i) a.in[i] = (const float*)d_in[i];
    a.out = (float*)d_out; a.ws = (unsigned char*)d_ws;
#if MK_N_LAUNCHES == 1
    a.ph_lo = 0; a.ph_hi = NPH;
    void* args[] = {&a};
    hipError_t e = hipLaunchCooperativeKernel((const void*)hymba_fwd, dim3(grid), dim3(512), args, LDS_BYTES, stream);
    if (e != hipSuccess) fprintf(stderr, "cooperative launch failed: %s (grid %d)\n", hipGetErrorString(e), grid);
#else
#ifdef DBG_STOP
    for (int ph = 0; ph <= DBG_STOP; ++ph) { a.ph_lo = ph; a.ph_hi = ph + 1; hipLaunchKernelGGL(hymba_fwd, dim3(grid), dim3(512), LDS_BYTES, stream, a); }
    hipLaunchKernelGGL(dbg_dump, dim3(2048), dim3(256), 0, stream, (const unsigned*)((unsigned char*)d_ws + DBG_SRC), (float*)d_out, (size_t)M * D);
#else
    for (int ph = 0; ph < NPH; ++ph) {
        a.ph_lo = ph; a.ph_hi = ph + 1;
        hipLaunchKernelGGL(hymba_fwd, dim3(grid), dim3(512), LDS_BYTES, stream, a);
    }
#endif
#endif
}
```

```cpp
#include <hip/hip_runtime.h>
#include <hip/hip_cooperative_groups.h>
#include <cstdio>
#include <cstdint>
namespace cg = cooperative_groups;
namespace pg8 {
#define PG8_LAS __attribute__((address_space(3)))
typedef unsigned short bf16_t;
typedef short bf16x8 __attribute__((ext_vector_type(8)));
typedef float f32x4 __attribute__((ext_vector_type(4)));
typedef unsigned u32x4 __attribute__((ext_vector_type(4)));
constexpr int BM = 256, BK = 64, HALF = 128, HTB = HALF * BK * 2  , STAGE_BYTES = 8 * HTB, NXCD = 8, WGM = 4;

__host__ __device__ __forceinline__ int lds_byte(int r, int c) { const int st = (r >> 4) * 2 + (c >> 5), rr = r & 15, cc = c & 31, ob = rr * 64 + cc * 2; return st * 1024 + (ob ^ (((ob >> 9) & 1) << 5)); }
__host__ __device__ __forceinline__ void stage_rc(int b, int& R, int& C) { const int st = b / 1024, sb = b % 1024, swz = sb ^ (((sb >> 9) & 1) << 5); R = (st >> 1) * 16 + swz / 64; C = (st & 1) * 32 + (swz % 64) / 2; }
__host__ __device__ __forceinline__ int perm32(int rho) { const int n = rho >> 4, i = rho & 15; return 8 * (i >> 2) + 4 * n + (i & 3); }

struct Unit { int pm, pn; };
struct Gemm { const bf16_t* A; const bf16_t* Bt; int M, N, K; };

struct StaticOrder {
    int nM, nN, nwg, G, c;
    __host__ __device__ void init(int M, int N, int G_, int c_) { nM = M / BM; nN = N / BM; nwg = nM * nN; G = G_; c = c_; }
    __host__ __device__ bool next(int i, Unit& u) const {
        const long L = (long)i * G + c; if (L >= nwg) return false;
        int wgid = (int)L; { const int q = nwg / NXCD, r = nwg % NXCD, xcd = wgid % NXCD, off = wgid / NXCD; wgid = (xcd < r ? xcd * (q + 1) : r * (q + 1) + (xcd - r) * q) + off; }
        const int nig = WGM * nN, gid = wgid / nig, fm = gid * WGM, gsz = (nM - fm) < WGM ? (nM - fm) : WGM;
        u.pm = fm + ((wgid % nig) % gsz); u.pn = (wgid % nig) / gsz; return true;
    }
    __device__ __forceinline__ void a_ready(const Unit&) const {}
    __device__ __forceinline__ void done(const Unit&) const {}
};
__device__ __forceinline__ unsigned cvt_pk_bf16(float lo, float hi) { unsigned r; asm volatile("v_cvt_pk_bf16_f32 %0, %1, %2" : "=v"(r) : "v"(lo), "v"(hi)); return r; }

template <class Epi, class Sched, bool ALIGN_EPI = false, bool SP2 = false>
__device__ __forceinline__ void gemm_phase(PG8_LAS unsigned char* lds, const Gemm g, const Sched& S, const Epi& E, const int wid) {
    int lane; asm volatile("v_mbcnt_lo_u32_b32 %0, -1, 0\n\tv_mbcnt_hi_u32_b32 %0, -1, %0" : "=v"(lane));
    const int tid = wid * 64 + lane, wr = wid >> 2, wc = wid & 3, fr = lane & 15, fq = lane >> 4;
    const int K = g.K, nt = K / BK;
    unsigned voffA[2], voffB[2];
#pragma unroll
    for (int i = 0; i < 2; ++i) { int R, C; stage_rc(tid * 16 + i * 8192, R, C); const int Rb = Epi::PERM ? ((R & ~31) + perm32(R & 31)) : R;
        voffA[i] = (unsigned)(R * K + C) * 2u; voffB[i] = (unsigned)(Rb * K + C) * 2u; }
    const size_t kstep = (size_t)(BK * 2);
    const size_t hstep = (size_t)HALF * K * 2;
    const size_t tstep = 2 * hstep;
    const unsigned ldsw = (unsigned)wid * 1024u;
    const int aoff = lds_byte(wr * 64 + fr, fq * 8), boff = lds_byte(wc * 32 + fr, fq * 8);
#define PG8_SA(b, h) (((b) * 2 + (h)) * HTB)
#define PG8_SB(b, h) ((4 + (b) * 2 + (h)) * HTB)
#define PG8_STAGE(bufoff, gbase, voff) do { _Pragma("unroll") for (int _i = 0; _i < 2; ++_i) \
        __builtin_amdgcn_global_load_lds((const unsigned*)((const char*)(gbase) + (voff)[_i]), (PG8_LAS unsigned*)(lds + (bufoff) + ldsw + _i * 8192), 16, 0, 0); } while (0)
#define PG8_LDA(dst, b, h) do { _Pragma("unroll") for (int m = 0; m < 4; ++m) _Pragma("unroll") for (int k = 0; k < 2; ++k) dst[m][k] = *(const PG8_LAS bf16x8*)(lds + PG8_SA(b, h) + aoff + m * 2048 + k * 1024); } while (0)
#define PG8_LDB(dst, b, h) do { _Pragma("unroll") for (int n = 0; n < 2; ++n) _Pragma("unroll") for (int k = 0; k < 2; ++k) dst[n][k] = *(const PG8_LAS bf16x8*)(lds + PG8_SB(b, h) + boff + n * 2048 + k * 1024); } while (0)
#define PG8_MMA(ai, bj, At, Bt) do { __builtin_amdgcn_s_setprio(1); _Pragma("unroll") for (int m = 0; m < 4; ++m) _Pragma("unroll") for (int n = 0; n < 2; ++n) _Pragma("unroll") for (int k = 0; k < 2; ++k) \
        acc[ai][bj][m][n] = __builtin_amdgcn_mfma_f32_16x16x32_bf16(Bt[n][k], At[m][k], acc[ai][bj][m][n], 0, 0, 0); __builtin_amdgcn_s_setprio(0); } while (0)
#define PG8_WAIT_V(n) asm volatile("s_waitcnt vmcnt(" #n ")" ::: "memory")
#define PG8_WAIT_L(n) asm volatile("s_waitcnt lgkmcnt(" #n ")" ::: "memory")
#define PG8_BAR __builtin_amdgcn_s_barrier()
#define PG8_SCHED __builtin_amdgcn_sched_barrier(0)
    Unit cur, nxt; int ui = 0;
    if (!S.next(0, cur)) return;
    f32x4 acc[2][2][4][2];
#pragma unroll
    for (int a = 0; a < 2; ++a)
#pragma unroll
        for (int b = 0; b < 2; ++b)
#pragma unroll
            for (int m = 0; m < 4; ++m)
#pragma unroll
                for (int n = 0; n < 2; ++n) acc[a][b][m][n] = (f32x4){0.f, 0.f, 0.f, 0.f};
    bf16x8 At[4][2], B0[2][2], B1[2][2];
    const char* cA = (const char*)g.A + (size_t)cur.pm * tstep; const char* cB = (const char*)g.Bt + (size_t)cur.pn * tstep;
    S.a_ready(cur);
    if constexpr (SP2) {
        PG8_STAGE(PG8_SB(0, 0), cB, voffB); PG8_STAGE(PG8_SB(0, 1), cB + hstep, voffB); PG8_STAGE(PG8_SA(0, 0), cA, voffA); PG8_STAGE(PG8_SA(0, 1), cA + hstep, voffA);
        if (wr == 1) PG8_BAR;
        PG8_WAIT_V(2); PG8_BAR;
        PG8_STAGE(PG8_SB(1, 0), cB + kstep, voffB); PG8_STAGE(PG8_SA(1, 0), cA + kstep, voffA); PG8_STAGE(PG8_SB(1, 1), cB + hstep + kstep, voffB);
        PG8_WAIT_V(6); PG8_BAR;
    } else {
        PG8_STAGE(PG8_SB(0, 0), cB, voffB); PG8_STAGE(PG8_SA(0, 0), cA, voffA); PG8_STAGE(PG8_SB(0, 1), cB + hstep, voffB); PG8_STAGE(PG8_SA(0, 1), cA + hstep, voffA);
        if (wr == 1) PG8_BAR;
        PG8_WAIT_V(4); PG8_BAR;
        PG8_STAGE(PG8_SB(1, 0), cB + kstep, voffB); PG8_STAGE(PG8_SA(1, 0), cA + kstep, voffA); PG8_STAGE(PG8_SB(1, 1), cB + hstep + kstep, voffB);
        PG8_WAIT_V(6); PG8_BAR;
    }
    for (;;) {
        const bool has_next = S.next(ui + 1, nxt);
        const char* nA = has_next ? (const char*)g.A + (size_t)nxt.pm * tstep : cA; const char* nB = has_next ? (const char*)g.Bt + (size_t)nxt.pn * tstep : cB;
        for (int t = 0; t < nt; t += 2) {
            if constexpr (Epi::HAS_HOOK) E.hook(t, acc, cur, wr, fr);
            const bool last = (t == nt - 2);
            const char* a1 = cA + (size_t)(t + 1) * kstep;
            const char* a2 = last ? nA : cA + (size_t)(t + 2) * kstep; const char* b2 = last ? nB : cB + (size_t)(t + 2) * kstep;
            const char* a3 = a2 + kstep; const char* b3 = b2 + kstep;
            if (last && has_next) S.a_ready(nxt);
            if constexpr (SP2) {
            PG8_LDB(B0, 0, 0); PG8_LDB(B1, 0, 1); PG8_SCHED; PG8_LDA(At, 0, 0); PG8_STAGE(PG8_SA(1, 1), a1 + hstep, voffA);
            PG8_WAIT_V(8); PG8_WAIT_L(0); PG8_BAR; PG8_MMA(0, 0, At, B0); PG8_MMA(0, 1, At, B1); PG8_BAR; PG8_SCHED;
            PG8_LDA(At, 0, 1); PG8_STAGE(PG8_SB(0, 0), b2, voffB); PG8_STAGE(PG8_SB(0, 1), b2 + hstep, voffB); PG8_STAGE(PG8_SA(0, 0), a2, voffA);
            PG8_WAIT_V(8); PG8_WAIT_L(0); PG8_BAR; PG8_MMA(1, 0, At, B0); PG8_MMA(1, 1, At, B1); PG8_BAR; PG8_SCHED;
            PG8_LDB(B0, 1, 0); PG8_LDB(B1, 1, 1); PG8_SCHED; PG8_LDA(At, 1, 0); PG8_STAGE(PG8_SA(0, 1), a2 + hstep, voffA);
            PG8_WAIT_V(8); PG8_WAIT_L(0); PG8_BAR; PG8_MMA(0, 0, At, B0); PG8_MMA(0, 1, At, B1); PG8_BAR; PG8_SCHED;
            PG8_LDA(At, 1, 1); PG8_STAGE(PG8_SB(1, 0), b3, voffB); PG8_STAGE(PG8_SB(1, 1), b3 + hstep, voffB); PG8_STAGE(PG8_SA(1, 0), a3, voffA);
            PG8_WAIT_V(8); PG8_WAIT_L(0); PG8_BAR; PG8_MMA(1, 0, At, B0); PG8_MMA(1, 1, At, B1); PG8_BAR; PG8_SCHED;
            } else {
            PG8_LDB(B0, 0, 0); PG8_SCHED; PG8_LDA(At, 0, 0); PG8_STAGE(PG8_SA(1, 1), a1 + hstep, voffA);
            PG8_WAIT_L(8); PG8_BAR; PG8_WAIT_L(0); PG8_MMA(0, 0, At, B0); PG8_BAR; PG8_SCHED;
            PG8_LDB(B1, 0, 1); PG8_STAGE(PG8_SB(0, 0), b2, voffB);
            PG8_BAR; PG8_WAIT_L(0); PG8_MMA(0, 1, At, B1); PG8_BAR;
            PG8_LDA(At, 0, 1); PG8_STAGE(PG8_SA(0, 0), a2, voffA);
            PG8_BAR; PG8_WAIT_L(0); PG8_MMA(1, 0, At, B0); PG8_BAR; PG8_SCHED;
            PG8_STAGE(PG8_SB(0, 1), b2 + hstep, voffB);
            PG8_WAIT_V(6); PG8_BAR; PG8_MMA(1, 1, At, B1); PG8_BAR;
            PG8_LDB(B0, 1, 0); PG8_SCHED; PG8_LDA(At, 1, 0); PG8_STAGE(PG8_SA(0, 1), a2 + hstep, voffA);
            PG8_WAIT_L(8); PG8_BAR; PG8_WAIT_L(0); PG8_MMA(0, 0, At, B0); PG8_BAR; PG8_SCHED;
            PG8_LDB(B1, 1, 1); PG8_STAGE(PG8_SB(1, 0), b3, voffB);
            PG8_BAR; PG8_WAIT_L(0); PG8_MMA(0, 1, At, B1); PG8_BAR;
            PG8_LDA(At, 1, 1); PG8_STAGE(PG8_SA(1, 0), a3, voffA);
            PG8_BAR; PG8_WAIT_L(0); PG8_MMA(1, 0, At, B0); PG8_BAR; PG8_SCHED;
            PG8_STAGE(PG8_SB(1, 1), b3 + hstep, voffB);
            PG8_WAIT_V(6); PG8_BAR; PG8_MMA(1, 1, At, B1); PG8_BAR;
            }
        }
        if constexpr (ALIGN_EPI) { if (wr == 0) PG8_BAR; }
        if constexpr (!Epi::AFTER_DRAIN) { E(acc, cur, wr, wc, fr, fq); S.done(cur); }
        if (!has_next) break;
#pragma unroll
        for (int a = 0; a < 2; ++a)
#pragma unroll
            for (int b = 0; b < 2; ++b)
#pragma unroll
                for (int m = 0; m < 4; ++m)
#pragma unroll
                    for (int n = 0; n < 2; ++n) acc[a][b][m][n] = (f32x4){0.f, 0.f, 0.f, 0.f};
        cur = nxt; cA = nA; cB = nB; ++ui;
        if constexpr (ALIGN_EPI) { if (wr == 1) PG8_BAR; }
    }
    PG8_WAIT_V(0);
    if constexpr (!ALIGN_EPI) { if (wr == 0) PG8_BAR; }
    PG8_BAR;
    if constexpr (Epi::AFTER_DRAIN) { E.fused(acc, cur, wr, wc, fr, fq, lds, wid, lane); S.done(cur); }
#undef PG8_SA
#undef PG8_SB
#undef PG8_STAGE
#undef PG8_LDA
#undef PG8_LDB
#undef PG8_MMA
#undef PG8_WAIT_V
#undef PG8_WAIT_L
#undef PG8_BAR
#undef PG8_SCHED
}
}

#ifndef MK_N_LAUNCHES
#define MK_N_LAUNCHES 1
#endif
constexpr int M = 65536, SEQ = 8192, D = 1024, NPROJ = 5144, NP = 5376, AW = 512, SW = 1536, CD = 2048, FF = 2816, PD = 256, NH = 24, MIXW = 2048;
constexpr int NPH = 10;
constexpr float EPS = 1e-6f;
constexpr float LOG2E = 1.4426950408889634f;
constexpr size_t MiB = 1u << 20;
constexpr size_t WS_SSQ1 = 0, WS_SSQ2 = 256 * 1024, WS_SSQT = 512 * 1024;
constexpr size_t WS_HALO = 1 * MiB;
constexpr size_t WS_DT = 4 * MiB, WS_ACS = 10 * MiB;
constexpr size_t WS_WIN = 16 * MiB, WS_WOUT = 27 * MiB, WS_WGU = 31 * MiB, WS_WDN = 42 * MiB, WS_WPG = 48 * MiB, WS_WPLE = 50 * MiB;
constexpr size_t WS_PB = 52 * MiB;
constexpr size_t WS_Q = 84 * MiB, WS_K = 148 * MiB, WS_V = 212 * MiB;
constexpr size_t WS_Z = 276 * MiB;
constexpr size_t WS_XBC = 468 * MiB;
constexpr size_t WS_MIX = 724 * MiB;
constexpr size_t WS_RS = 980 * MiB;
constexpr size_t WS_END = 981 * MiB;
constexpr size_t WS_XB = WS_Q;
constexpr size_t WS_HMID = WS_Z;
constexpr size_t WS_T = WS_MIX;
static_assert(WS_HMID + (size_t)M * FF * 2 <= WS_MIX, "hmid overlay");

#define LAS __attribute__((address_space(3)))
typedef unsigned short bf16;
using pg8::bf16x8; using pg8::f32x4; using pg8::u32x4; using pg8::Unit;
typedef unsigned u32x2 __attribute__((ext_vector_type(2)));

typedef float f32x2_t __attribute__((ext_vector_type(2)));
typedef __bf16 bf16x2_t __attribute__((ext_vector_type(2)));
__device__ __forceinline__ unsigned pk(float lo, float hi) { f32x2_t v = {lo, hi}; bf16x2_t b = __builtin_convertvector(v, bf16x2_t); return __builtin_bit_cast(unsigned, b); }
__device__ __forceinline__ bf16x8 pack8(f32x4 a, f32x4 b) { u32x4 w; w.x = pk(a[0], a[1]); w.y = pk(a[2], a[3]); w.z = pk(b[0], b[1]); w.w = pk(b[2], b[3]); return __builtin_bit_cast(bf16x8, w); }
__device__ __forceinline__ u32x4 pack8u(f32x4 a, f32x4 b) { u32x4 w; w.x = pk(a[0], a[1]); w.y = pk(a[2], a[3]); w.z = pk(b[0], b[1]); w.w = pk(b[2], b[3]); return w; }
__device__ __forceinline__ float bflo(unsigned u) { return __uint_as_float(u << 16); }
__device__ __forceinline__ float bfhi(unsigned u) { return __uint_as_float(u & 0xffff0000u); }
__device__ __forceinline__ float ex2(float x) { return __builtin_amdgcn_exp2f(x); }
__device__ __forceinline__ float fexp(float x) { return __builtin_amdgcn_exp2f(x * LOG2E); }
__device__ __forceinline__ float sigm(float x) { return __builtin_amdgcn_rcpf(1.f + fexp(-x)); }
__device__ __forceinline__ f32x4 mfma16(bf16x8 a, bf16x8 b, f32x4 c) { return __builtin_amdgcn_mfma_f32_16x16x32_bf16(a, b, c, 0, 0, 0); }
__device__ __forceinline__ float wave_sum(float v) {
#pragma unroll
    for (int o = 1; o < 64; o <<= 1) v += __shfl_xor(v, o);
    return v;
}
typedef unsigned u32x2s __attribute__((ext_vector_type(2)));
__device__ __forceinline__ float red_max_g4(float x) {
    const unsigned u = __float_as_uint(x); const u32x2s r = __builtin_amdgcn_permlane16_swap(u, u, false, false);
    const float m = fmaxf(__uint_as_float(r.x), __uint_as_float(r.y));
    const unsigned v = __float_as_uint(m); const u32x2s s = __builtin_amdgcn_permlane32_swap(v, v, false, false);
    return fmaxf(__uint_as_float(s.x), __uint_as_float(s.y));
}
__device__ __forceinline__ float red_sum_g4(float x) {
    const unsigned u = __float_as_uint(x); const u32x2s r = __builtin_amdgcn_permlane16_swap(u, u, false, false);
    const float m = __uint_as_float(r.x) + __uint_as_float(r.y);
    const unsigned v = __float_as_uint(m); const u32x2s s = __builtin_amdgcn_permlane32_swap(v, v, false, false);
    return __uint_as_float(s.x) + __uint_as_float(s.y);
}
__device__ __forceinline__ int kkmap(int m, int hf) { return 8 * (m >> 2) + 4 * hf + (m & 3); }

struct EpiInProj {
    static constexpr bool PERM = true, AFTER_DRAIN = false, HAS_HOOK = false;
    unsigned char* ws; const float *qn, *kn, *dtb;
    __device__ __forceinline__ void operator()(const f32x4 (&acc)[2][2][4][2], const Unit& u, int wr, int wc, int fr, int fq) const {
        const int pn = u.pn; const int row0 = u.pm * 256 + wr * 64 + fr;
        if (pn < 4) {
            const bool isq = pn < 2; const float* gn = isq ? qn : kn; bf16* dst = (bf16*)(ws + (isq ? WS_Q : WS_K));
            const float sc = isq ? 0.125f * LOG2E : 1.f;
            const int hd = 4 * (pn & 1) + wc;
            f32x4 gv[2][2];
#pragma unroll
            for (int bj = 0; bj < 2; ++bj)
#pragma unroll
                for (int n = 0; n < 2; ++n) gv[bj][n] = *(const f32x4*)(gn + 32 * bj + 8 * fq + 4 * n) * sc;
#pragma unroll
            for (int ai = 0; ai < 2; ++ai)
#pragma unroll
                for (int m = 0; m < 4; ++m) {
                    float ss = 0.f;
#pragma unroll
                    for (int bj = 0; bj < 2; ++bj)
#pragma unroll
                        for (int n = 0; n < 2; ++n) { const f32x4 x = acc[ai][bj][m][n]; ss += (x[0] * x[0] + x[1] * x[1]) + (x[2] * x[2] + x[3] * x[3]); }
                    ss = red_sum_g4(ss);
                    const float rs = rsqrtf(ss * (1.f / 64.f) + EPS);
                    bf16* rowp = dst + (size_t)(row0 + ai * 128 + m * 16) * AW + hd * 64 + 8 * fq;
#pragma unroll
                    for (int bj = 0; bj < 2; ++bj) *(u32x4*)(rowp + 32 * bj) = pack8u(acc[ai][bj][m][0] * rs * gv[bj][0], acc[ai][bj][m][1] * rs * gv[bj][1]);
                }
        } else if (pn < 20) {
            int ldc, colt; size_t woff;
            if (pn < 6) { woff = WS_V; ldc = AW; colt = (pn - 4) * 256; } else if (pn < 12) { woff = WS_Z; ldc = SW; colt = (pn - 6) * 256; } else { woff = WS_XBC; ldc = CD; colt = (pn - 12) * 256; }
            bf16* dst = (bf16*)(ws + woff);
            const int col0 = colt + wc * 32 + 8 * fq;
#pragma unroll
            for (int ai = 0; ai < 2; ++ai)
#pragma unroll
                for (int m = 0; m < 4; ++m) {
                    bf16* rowp = dst + (size_t)(row0 + ai * 128 + m * 16) * ldc + col0;
#pragma unroll
                    for (int bj = 0; bj < 2; ++bj) *(u32x4*)(rowp + bj * 128) = pack8u(acc[ai][bj][m][0], acc[ai][bj][m][1]);
                }
            if (pn >= 12 && wr == 1 && fr >= 13) {
                bf16* hp = (bf16*)(ws + WS_HALO) + ((size_t)u.pm * 3 + (fr - 13)) * CD + col0;
#pragma unroll
                for (int bj = 0; bj < 2; ++bj) *(u32x4*)(hp + bj * 128) = pack8u(acc[1][bj][3][0], acc[1][bj][3][1]);
            }
        } else {
            if (wc == 0 && fq < 3) {
                f32x4 bv[2];
#pragma unroll
                for (int n = 0; n < 2; ++n) bv[n] = *(const f32x4*)(dtb + 8 * fq + 4 * n);
#pragma unroll
                for (int ai = 0; ai < 2; ++ai)
#pragma unroll
                    for (int m = 0; m < 4; ++m) {
                        float* rowp = (float*)(ws + WS_DT) + (size_t)(row0 + ai * 128 + m * 16) * NH + 8 * fq;
#pragma unroll
                        for (int n = 0; n < 2; ++n) { f32x4 x = acc[ai][0][m][n] + bv[n], o;
#pragma unroll
                            for (int e = 0; e < 4; ++e) o[e] = fmaxf(x[e], 0.f) + log1pf(fexp(-fabsf(x[e])));
                            *(f32x4*)(rowp + 4 * n) = o; }
                    }
            }
        }
    }
};

template <bool HOOK> struct EpiResNorm {
    static constexpr bool PERM = true, AFTER_DRAIN = false, HAS_HOOK = HOOK;
    const float* base; float* out; bf16* xb; const float* gain; float* ssq; const float* rsg;
    __device__ __forceinline__ void hook(int t, f32x4 (&acc)[2][2][4][2], const Unit& u, int wr, int fr) const {
        if (t != 12 && t != 24) return;
        const int row0 = u.pm * 256 + wr * 64 + fr;
#pragma unroll
        for (int ai = 0; ai < 2; ++ai)
#pragma unroll
            for (int m = 0; m < 4; ++m) {
                const float r0 = rsg[2 * (row0 + ai * 128 + m * 16)], r1 = rsg[2 * (row0 + ai * 128 + m * 16) + 1];
                const float sc = (t == 12) ? r0 / r1 : r1;
#pragma unroll
                for (int bj = 0; bj < 2; ++bj)
#pragma unroll
                    for (int n = 0; n < 2; ++n) acc[ai][bj][m][n] *= sc;
            }
    }
    __device__ __forceinline__ void operator()(const f32x4 (&acc)[2][2][4][2], const Unit& u, int wr, int wc, int fr, int fq) const {
        const int row0 = u.pm * 256 + wr * 64 + fr, col0 = u.pn * 256 + wc * 32 + 8 * fq;
        f32x4 gv[2][2];
#pragma unroll
        for (int bj = 0; bj < 2; ++bj)
#pragma unroll
            for (int n = 0; n < 2; ++n) gv[bj][n] = *(const f32x4*)(gain + col0 + bj * 128 + 4 * n);
        f32x4 xin[2][2][2];
#pragma unroll
        for (int bj = 0; bj < 2; ++bj)
#pragma unroll
            for (int n = 0; n < 2; ++n) xin[0][bj][n] = *(const f32x4*)(base + (size_t)row0 * D + col0 + bj * 128 + 4 * n);
#pragma unroll
        for (int i = 0; i < 8; ++i) {
            const int ai = i >> 2, m = i & 3, r = row0 + ai * 128 + m * 16;
            if (i + 1 < 8) { const int rn = row0 + ((i + 1) >> 2) * 128 + ((i + 1) & 3) * 16;
#pragma unroll
                for (int bj = 0; bj < 2; ++bj)
#pragma unroll
                    for (int n = 0; n < 2; ++n) xin[(i + 1) & 1][bj][n] = *(const f32x4*)(base + (size_t)rn * D + col0 + bj * 128 + 4 * n); }
            float ss = 0.f;
#pragma unroll
            for (int bj = 0; bj < 2; ++bj) {
                const size_t off = (size_t)r * D + col0 + bj * 128;
                const f32x4 v0 = xin[i & 1][bj][0] + acc[ai][bj][m][0], v1 = xin[i & 1][bj][1] + acc[ai][bj][m][1];
                *(f32x4*)(out + off) = v0; *(f32x4*)(out + off + 4) = v1;
                ss += (v0[0] * v0[0] + v0[1] * v0[1]) + (v0[2] * v0[2] + v0[3] * v0[3]) + (v1[0] * v1[0] + v1[1] * v1[1]) + (v1[2] * v1[2] + v1[3] * v1[3]);
                *(u32x4*)(xb + off) = pack8u(v0 * gv[bj][0], v1 * gv[bj][1]);
            }
            ss = red_sum_g4(ss);
            if (fq == 0) unsafeAtomicAdd(ssq + r, ss);
        }
    }
};

struct EpiSwiGLU {
    static constexpr bool PERM = true, AFTER_DRAIN = false, HAS_HOOK = false;
    const float* ssq; bf16* h;
    __device__ __forceinline__ void operator()(const f32x4 (&acc)[2][2][4][2], const Unit& u, int wr, int wc, int fr, int fq) const {
        const int row0 = u.pm * 256 + wr * 64 + fr, col0 = u.pn * 128 + wc * 32 + 8 * fq;
        float sq8[2][4];
#pragma unroll
        for (int ai = 0; ai < 2; ++ai)
#pragma unroll
            for (int m = 0; m < 4; ++m) sq8[ai][m] = ssq[row0 + ai * 128 + m * 16];
#pragma unroll
        for (int ai = 0; ai < 2; ++ai)
#pragma unroll
            for (int m = 0; m < 4; ++m) {
                const int r = row0 + ai * 128 + m * 16;
                const float rs = rsqrtf(sq8[ai][m] * (1.f / D) + EPS);
                f32x4 hv[2];
#pragma unroll
                for (int n = 0; n < 2; ++n) { const f32x4 g = acc[ai][0][m][n] * rs, uu = acc[ai][1][m][n] * rs;
#pragma unroll
                    for (int e = 0; e < 4; ++e) hv[n][e] = g[e] * sigm(g[e]) * uu[e]; }
                *(u32x4*)(h + (size_t)r * FF + col0) = pack8u(hv[0], hv[1]);
            }
    }
};

struct EpiPle {
    static constexpr bool PERM = true, AFTER_DRAIN = false, HAS_HOOK = false;
    bf16* t; float* ssq;
    __device__ __forceinline__ void operator()(const f32x4 (&acc)[2][2][4][2], const Unit& u, int wr, int wc, int fr, int fq) const {
        const int row0 = u.pm * 256 + wr * 64 + fr, col0 = u.pn * 256 + wc * 32 + 8 * fq;
#pragma unroll
        for (int ai = 0; ai < 2; ++ai)
#pragma unroll
            for (int m = 0; m < 4; ++m) {
                const int r = row0 + ai * 128 + m * 16; float ss = 0.f;
#pragma unroll
                for (int bj = 0; bj < 2; ++bj) {
                    const f32x4 v0 = acc[ai][bj][m][0], v1 = acc[ai][bj][m][1];
                    ss += (v0[0] * v0[0] + v0[1] * v0[1]) + (v0[2] * v0[2] + v0[3] * v0[3]) + (v1[0] * v1[0] + v1[1] * v1[1]) + (v1[2] * v1[2] + v1[3] * v1[3]);
                    *(u32x4*)(t + (size_t)r * D + col0 + bj * 128) = pack8u(v0, v1);
                }
                ss = red_sum_g4(ss);
                if (fq == 0) unsafeAtomicAdd(ssq + r, ss);
            }
    }
};

struct EpiFinal {
    static constexpr bool PERM = true, AFTER_DRAIN = false, HAS_HOOK = false;
    float* out; const bf16* t; const float *ssq2, *ssqt, *bias, *png;
    __device__ __forceinline__ void operator()(const f32x4 (&acc)[2][2][4][2], const Unit& u, int wr, int wc, int fr, int fq) const {
        const int row0 = u.pm * 256 + wr * 64 + fr, col0 = u.pn * 256 + wc * 32 + 8 * fq;
        f32x4 bv[2][2], gv[2][2];
#pragma unroll
        for (int bj = 0; bj < 2; ++bj)
#pragma unroll
            for (int n = 0; n < 2; ++n) { bv[bj][n] = *(const f32x4*)(bias + col0 + bj * 128 + 4 * n); gv[bj][n] = *(const f32x4*)(png + col0 + bj * 128 + 4 * n); }
        f32x4 xin[2][2][2]; u32x4 tin[2][2]; float q2[2], qt[2];
        q2[0] = ssq2[row0]; qt[0] = ssqt[row0];
#pragma unroll
        for (int bj = 0; bj < 2; ++bj) { const size_t off = (size_t)row0 * D + col0 + bj * 128; tin[0][bj] = *(const u32x4*)(t + off); xin[0][bj][0] = *(const f32x4*)(out + off); xin[0][bj][1] = *(const f32x4*)(out + off + 4); }
#pragma unroll
        for (int i = 0; i < 8; ++i) {
            const int ai = i >> 2, m = i & 3, r = row0 + ai * 128 + m * 16;
            if (i + 1 < 8) { const int rn = row0 + ((i + 1) >> 2) * 128 + ((i + 1) & 3) * 16; q2[(i + 1) & 1] = ssq2[rn]; qt[(i + 1) & 1] = ssqt[rn];
#pragma unroll
                for (int bj = 0; bj < 2; ++bj) { const size_t off = (size_t)rn * D + col0 + bj * 128; tin[(i + 1) & 1][bj] = *(const u32x4*)(t + off); xin[(i + 1) & 1][bj][0] = *(const f32x4*)(out + off); xin[(i + 1) & 1][bj][1] = *(const f32x4*)(out + off + 4); } }
            const float rs2 = rsqrtf(q2[i & 1] * (1.f / D) + EPS), rst = rsqrtf(qt[i & 1] * (1.f / D) + EPS);
#pragma unroll
            for (int bj = 0; bj < 2; ++bj) {
                const size_t off = (size_t)r * D + col0 + bj * 128;
                const u32x4 tw = tin[i & 1][bj];
                f32x4 tv[2] = {{bflo(tw.x), bfhi(tw.x), bflo(tw.y), bfhi(tw.y)}, {bflo(tw.z), bfhi(tw.z), bflo(tw.w), bfhi(tw.w)}};
#pragma unroll
                for (int n = 0; n < 2; ++n) {
                    const f32x4 x2 = xin[i & 1][bj][n]; const f32x4 a = acc[ai][bj][m][n] * rs2 + bv[bj][n]; f32x4 o;
#pragma unroll
                    for (int e = 0; e < 4; ++e) o[e] = x2[e] + sigm(a[e]) * (tv[n][e] * rst * gv[bj][n][e]);
                    *(f32x4*)(out + off + 4 * n) = o;
                }
            }
        }
    }
};

__device__ __forceinline__ void make_isel(int lane, bf16x8 (&isel)[2]) {
    const int c = lane & 15, g4 = lane >> 4;
#pragma unroll
    for (int o = 0; o < 2; ++o)
#pragma unroll
        for (int j = 0; j < 8; ++j) isel[o][j] = (8 * g4 + j == 16 * o + c) ? (short)0x3F80 : (short)0;
}
struct Args { const float* in[22]; float* out; unsigned char* ws; int ph_lo, ph_hi; };

__device__ __forceinline__ void transpose_item(const float* colp, int ld, int K, bf16* WT, int k0, int n0, LAS float* scr, int lane, const float* kgain = nullptr) {
#pragma unroll 8
    for (int i = 0; i < 32; ++i) { const int kk = 2 * i + (lane >> 5); const float gsc = kgain ? kgain[k0 + kk] : 1.f; scr[kk * 33 + (lane & 31)] = colp ? colp[(ptrdiff_t)(k0 + kk) * ld] * gsc : 0.f; }
    asm volatile("s_waitcnt lgkmcnt(0)" ::: "memory");
    const int c = lane & 7;
#pragma unroll
    for (int j = 0; j < 4; ++j) { const int n = (lane >> 3) + 8 * j; const LAS float* s = scr + (8 * c) * 33 + n;
        u32x4 o; o.x = pk(s[0 * 33], s[1 * 33]); o.y = pk(s[2 * 33], s[3 * 33]); o.z = pk(s[4 * 33], s[5 * 33]); o.w = pk(s[6 * 33], s[7 * 33]);
        *(u32x4*)(WT + (size_t)(n0 + n) * K + k0 + 8 * c) = o; }
    asm volatile("s_waitcnt lgkmcnt(0)" ::: "memory");
}

__device__ __forceinline__ void p0_prologue(const Args& a, LAS unsigned char* lds, int tid, int lane, int wave, int G) {
    unsigned char* ws = a.ws;
    LAS float* scr = (LAS float*)(lds + wave * 16384);
    const int gw = blockIdx.x * 8 + wave, NGW = G * 8;
    constexpr int I_IN = (D / 64) * (NP / 32), I_OUT = (MIXW / 64) * (D / 32), I_GU = (D / 64) * (2 * FF / 32), I_DN = (FF / 64) * (D / 32), I_PG = (D / 64) * (D / 32), I_PLE = (PD / 64) * (D / 32);
    constexpr int NITEMS = I_IN + I_OUT + I_GU + I_DN + I_PG + I_PLE;
    for (int it = gw; it < NITEMS; it += NGW) {
        int r = it;
        if (r < I_IN) {
            const int nblk = NP / 32, kb = r / nblk, nb = r % nblk, np = nb * 32 + (lane & 31); int col;
            if (np < 1024) { const int seg = np >> 9, p = np & 511, tile = p >> 8, pos = p & 255, bj = pos >> 7, wc = (pos & 127) >> 5, j = pos & 31; col = seg * 512 + (4 * tile + wc) * 64 + 32 * bj + j; }
            else col = np;
            transpose_item(col < NPROJ ? a.in[3] + col : nullptr, NPROJ, D, (bf16*)(ws + WS_WIN), 64 * kb, 32 * nb, scr, lane); continue; }
        r -= I_IN;
        if (r < I_OUT) {
            const int nblk = D / 32, kb = r / nblk, nb = r % nblk, k0 = 64 * kb; const int srck0 = k0 < SW ? AW + k0 : k0 - SW;
            transpose_item(a.in[12] + (ptrdiff_t)(srck0 - k0) * D + nb * 32 + (lane & 31), D, MIXW, (bf16*)(ws + WS_WOUT), k0, 32 * nb, scr, lane, k0 < SW ? a.in[11] : nullptr); continue; }
        r -= I_OUT;
        if (r < I_GU) {
            const int nblk = 2 * FF / 32, kb = r / nblk, nb = r % nblk, np = nb * 32 + (lane & 31);
            const int pn = np >> 8, pos = np & 255, bj = pos >> 7, wc = (pos & 127) >> 5, j = pos & 31, ff = 128 * pn + 32 * wc + j;
            transpose_item((bj ? a.in[15] : a.in[14]) + ff, FF, D, (bf16*)(ws + WS_WGU), 64 * kb, 32 * nb, scr, lane); continue; }
        r -= I_GU;
        if (r < I_DN) { const int nblk = D / 32, kb = r / nblk, nb = r % nblk; transpose_item(a.in[16] + nb * 32 + (lane & 31), D, FF, (bf16*)(ws + WS_WDN), 64 * kb, 32 * nb, scr, lane); continue; }
        r -= I_DN;
        if (r < I_PG) { const int nblk = D / 32, kb = r / nblk, nb = r % nblk; transpose_item(a.in[18] + nb * 32 + (lane & 31), D, D, (bf16*)(ws + WS_WPG), 64 * kb, 32 * nb, scr, lane); continue; }
        r -= I_PG;
        { const int nblk = D / 32, kb = r / nblk, nb = r % nblk; transpose_item(a.in[20] + nb * 32 + (lane & 31), D, PD, (bf16*)(ws + WS_WPLE), 64 * kb, 32 * nb, scr, lane); }
    }
    {
        bf16* h0 = (bf16*)a.out; const float* x = a.in[0]; const float* gn = a.in[2];
        f32x4 g4v[4];
#pragma unroll
        for (int j = 0; j < 4; ++j) g4v[j] = *(const f32x4*)(gn + 4 * (64 * j + lane));
        for (int m0 = gw; m0 < M; m0 += 4 * NGW) {
            f32x4 v[4][4];
#pragma unroll
            for (int rr = 0; rr < 4; ++rr) { const int m = m0 + rr * NGW; if (m < M) { const f32x4* xr = (const f32x4*)(x + (size_t)m * D) + lane;
#pragma unroll
                for (int j = 0; j < 4; ++j) v[rr][j] = xr[64 * j]; } }
#pragma unroll
            for (int rr = 0; rr < 4; ++rr) { const int m = m0 + rr * NGW; if (m < M) {
                float sacc = 0.f;
#pragma unroll
                for (int j = 0; j < 4; ++j) sacc += (v[rr][j][0] * v[rr][j][0] + v[rr][j][1] * v[rr][j][1]) + (v[rr][j][2] * v[rr][j][2] + v[rr][j][3] * v[rr][j][3]);
                const float rs = rsqrtf(wave_sum(sacc) * (1.f / D) + EPS);
                u32x2* o8 = (u32x2*)(h0 + (size_t)m * D) + lane;
#pragma unroll
                for (int j = 0; j < 4; ++j) { const f32x4 w = v[rr][j] * rs * g4v[j]; u32x2 o; o.x = pk(w[0], w[1]); o.y = pk(w[2], w[3]); o8[64 * j] = o; } } }
        }
    }
    {
        const int gt = blockIdx.x * 512 + tid, NT = G * 512;
        const f32x4* p4 = (const f32x4*)a.in[1]; u32x4* pb = (u32x4*)(ws + WS_PB);
        for (int i0 = gt; i0 < M * PD / 8; i0 += 4 * NT) {
            f32x4 v[4][2];
#pragma unroll
            for (int j = 0; j < 4; ++j) { const int i = i0 + j * NT; if (i < M * PD / 8) { v[j][0] = p4[2 * i]; v[j][1] = p4[2 * i + 1]; } }
#pragma unroll
            for (int j = 0; j < 4; ++j) { const int i = i0 + j * NT; if (i < M * PD / 8) pb[i] = pack8u(v[j][0], v[j][1]); }
        }
        float* sq = (float*)(ws + WS_SSQ1);
        for (int i = gt; i < 3 * M; i += NT) sq[i] = 0.f;
    }
}

__device__ __forceinline__ void conv_unit(const Args& a, int pm, int cs, int tid) {
    bf16* xbc = (bf16*)(a.ws + WS_XBC); const bf16* halo = (const bf16*)(a.ws + WS_HALO);
    const int cg8 = tid & 31, rseg = tid >> 5, col = cs * 256 + cg8 * 8, r0 = pm * 256 + rseg * 16;
    u32x4 raw[19];
#pragma unroll
    for (int i = 0; i < 3; ++i) {
        if (rseg > 0) raw[i] = *(const u32x4*)(xbc + (size_t)(r0 - 3 + i) * CD + col);
        else if ((pm & 31) != 0) raw[i] = *(const u32x4*)(halo + ((size_t)(pm - 1) * 3 + i) * CD + col);
        else raw[i] = (u32x4){0u, 0u, 0u, 0u};
    }
#pragma unroll
    for (int i = 0; i < 16; ++i) raw[3 + i] = *(const u32x4*)(xbc + (size_t)(r0 + i) * CD + col);
    f32x4 w[4][2], bv[2];
#pragma unroll
    for (int k = 0; k < 4; ++k) { w[k][0] = *(const f32x4*)(a.in[6] + k * CD + col); w[k][1] = *(const f32x4*)(a.in[6] + k * CD + col + 4); }
    bv[0] = *(const f32x4*)(a.in[7] + col); bv[1] = *(const f32x4*)(a.in[7] + col + 4);
    asm volatile("s_waitcnt vmcnt(0)" ::: "memory");
    __syncthreads();
#pragma unroll
    for (int i = 0; i < 16; ++i) {
        f32x4 acc0 = bv[0], acc1 = bv[1];
#pragma unroll
        for (int k = 0; k < 4; ++k) { const u32x4 u = raw[i + k];
            acc0 += w[k][0] * (f32x4){bflo(u.x), bfhi(u.x), bflo(u.y), bfhi(u.y)}; acc1 += w[k][1] * (f32x4){bflo(u.z), bfhi(u.z), bflo(u.w), bfhi(u.w)}; }
#pragma unroll
        for (int e = 0; e < 4; ++e) { acc0[e] = acc0[e] * sigm(acc0[e]); acc1[e] = acc1[e] * sigm(acc1[e]); }
        *(u32x4*)(xbc + (size_t)(r0 + i) * CD + col) = pack8u(acc0, acc1);
    }
}

__device__ __forceinline__ void acs_task(const Args& a, int task, int lane) {
    const float* dt = (const float*)(a.ws + WS_DT); float* acs = (float*)(a.ws + WS_ACS);
    const int cidx = task / NH, h = task % NH; const float av = -fexp(a.in[9][h]);
    const size_t r0 = (size_t)cidx * 128 + 2 * lane;
    const float v = dt[r0 * NH + h] * av, w = dt[(r0 + 1) * NH + h] * av;
    float s = v + w;
#pragma unroll
    for (int o = 1; o < 64; o <<= 1) { const float t = __shfl_up(s, o); if (lane >= o) s += t; }
    const float ex = s - (v + w);
    acs[r0 * NH + h] = ex + v; acs[(r0 + 1) * NH + h] = ex + v + w;
}

template <int DIL>
__device__ __forceinline__ void attn_pattern(const bf16* Kp, const bf16* Vp, size_t browbase, int hd, int T0, int r, int c, int g4,
                                             const bf16x8 (&qf)[2], const bf16x8 (&isel)[2], f32x4 (&o)[4], float& m_run, float& l_run) {
    constexpr int G = 16 / DIL, NT = DIL == 1 ? 12 : (DIL == 4 ? 6 : 5);
    const int rm = r % DIL, S0 = (T0 + r - rm) / DIL, s_lo = (S0 - 128) & ~7;
    const int sq = S0 + G * c;
    const int wlo = sq - 128 > 0 ? sq - 128 : 0; const unsigned wspan = (unsigned)(sq - wlo); const int kbase = s_lo + 8 * g4 - wlo;
    bf16x8 kb_[3][2][2], vb_[3][2][2];
    auto load_tile = [&](int tt, bf16x8 (&kk_)[2][2], bf16x8 (&vv_)[2][2]) {
#pragma unroll
        for (int hf = 0; hf < 2; ++hf) {
            int s = s_lo + 32 * tt + kkmap(c, hf); s = s < 0 ? 0 : s;
            int tok = s * DIL + rm; tok = tok > SEQ - 1 ? SEQ - 1 : tok;
            const size_t off = (browbase + tok) * AW + hd * 64 + 8 * g4;
#pragma unroll
            for (int ks = 0; ks < 2; ++ks) { kk_[hf][ks] = *(const bf16x8*)(Kp + off + 32 * ks); vv_[hf][ks] = *(const bf16x8*)(Vp + off + 32 * ks); }
        }
    };
    load_tile(0, kb_[0], vb_[0]); load_tile(1, kb_[1], vb_[1]);
#pragma unroll
    for (int tt = 0; tt < NT; ++tt) {
        if (tt + 2 < NT) load_tile(tt + 2, kb_[(tt + 2) % 3], vb_[(tt + 2) % 3]);
        const bf16x8 (&kf)[2][2] = kb_[tt % 3]; const bf16x8 (&vf)[2][2] = vb_[tt % 3];
        f32x4 sacc[2];
#pragma unroll
        for (int hf = 0; hf < 2; ++hf) { sacc[hf] = mfma16(kf[hf][0], qf[0], (f32x4){0.f, 0.f, 0.f, 0.f}); sacc[hf] = mfma16(kf[hf][1], qf[1], sacc[hf]); }
        float tmax = -INFINITY;
#pragma unroll
        for (int hf = 0; hf < 2; ++hf)
#pragma unroll
            for (int e = 0; e < 4; ++e) { const bool ok = (unsigned)(kbase + 32 * tt + 4 * hf + e) <= wspan;
                sacc[hf][e] = ok ? sacc[hf][e] : -INFINITY; tmax = fmaxf(tmax, sacc[hf][e]); }
        tmax = red_max_g4(tmax);
        if (__builtin_amdgcn_ballot_w64(tmax > m_run + 8.f) != 0ull) {
            const float m_new = fmaxf(m_run, tmax), m_u = (m_new == -INFINITY) ? 0.f : m_new, alpha = ex2(m_run - m_u);
            l_run *= alpha; m_run = m_new;
#pragma unroll
            for (int dvt = 0; dvt < 4; ++dvt) o[dvt] = o[dvt] * alpha;
        }
        const float m_use = (m_run == -INFINITY) ? 0.f : m_run;
        float ps = 0.f;
#pragma unroll
        for (int hf = 0; hf < 2; ++hf)
#pragma unroll
            for (int e = 0; e < 4; ++e) { sacc[hf][e] = ex2(sacc[hf][e] - m_use); ps += sacc[hf][e]; }
        l_run += ps;
        const bf16x8 pf = pack8(sacc[0], sacc[1]);
#pragma unroll
        for (int dvt = 0; dvt < 4; ++dvt) {
            const f32x4 z4 = {0.f, 0.f, 0.f, 0.f};
            const f32x4 t0 = mfma16(vf[0][dvt >> 1], isel[dvt & 1], z4), t1 = mfma16(vf[1][dvt >> 1], isel[dvt & 1], z4);
            o[dvt] = mfma16(pack8(t0, t1), pf, o[dvt]);
        }
    }
}

__device__ __forceinline__ void attn_tile(const bf16x8 (&kf)[2][2], const bf16x8 (&vt)[4], const bf16x8 (&qf)[2], const bf16x8 (&isel)[2], int s0, int sq, int g4,
                                          f32x4 (&o)[4], float& m_run, float& l_run) {
    const f32x4 z4 = {0.f, 0.f, 0.f, 0.f};
    f32x4 sacc[2];
#pragma unroll
    for (int hf = 0; hf < 2; ++hf) { sacc[hf] = mfma16(kf[hf][0], qf[0], z4); sacc[hf] = mfma16(kf[hf][1], qf[1], sacc[hf]); }
    const int wlo = sq - 128 > 0 ? sq - 128 : 0; const unsigned wspan = (unsigned)(sq - wlo); const int kbase = s0 + 8 * g4 - wlo;
    float tmax = -INFINITY;
#pragma unroll
    for (int hf = 0; hf < 2; ++hf)
#pragma unroll
        for (int e = 0; e < 4; ++e) { const bool ok = (unsigned)(kbase + 4 * hf + e) <= wspan;
            sacc[hf][e] = ok ? sacc[hf][e] : -INFINITY; tmax = fmaxf(tmax, sacc[hf][e]); }
    tmax = red_max_g4(tmax);
    if (__builtin_amdgcn_ballot_w64(tmax > m_run + 8.f) != 0ull) {
        const float m_new = fmaxf(m_run, tmax), m_u = (m_new == -INFINITY) ? 0.f : m_new, alpha = ex2(m_run - m_u);
        l_run *= alpha; m_run = m_new;
#pragma unroll
        for (int dvt = 0; dvt < 4; ++dvt) o[dvt] = o[dvt] * alpha;
    }
    const float m_use = (m_run == -INFINITY) ? 0.f : m_run;
    float ps = 0.f;
#pragma unroll
    for (int hf = 0; hf < 2; ++hf)
#pragma unroll
        for (int e = 0; e < 4; ++e) { sacc[hf][e] = ex2(sacc[hf][e] - m_use); ps += sacc[hf][e]; }
    l_run += ps;
    const bf16x8 pf = pack8(sacc[0], sacc[1]);
#pragma unroll
    for (int dvt = 0; dvt < 4; ++dvt) o[dvt] = mfma16(vt[dvt], pf, o[dvt]);
}
typedef short s16x4 __attribute__((ext_vector_type(4)));
template <int NT>
__device__ __forceinline__ void attn_lds_pattern(const LAS unsigned char* Kl, const LAS unsigned char* Vl, int ldsrow0, int s_lo, int sq, int c, int g4,
                                                 const bf16x8 (&qf)[2], const bf16x8 (&isel)[2], f32x4 (&o)[4], float& m_run, float& l_run) {
#pragma unroll 2
    for (int tt = 0; tt < NT; ++tt) {
        bf16x8 kf[2][2], vt[4];
#pragma unroll
        for (int hf = 0; hf < 2; ++hf) { const int off = (ldsrow0 + 32 * tt + kkmap(c, hf)) * 144 + 16 * g4;
#pragma unroll
            for (int ks = 0; ks < 2; ++ks) kf[hf][ks] = *(const LAS bf16x8*)(Kl + off + 64 * ks); }
        const LAS unsigned char* vb = Vl + (ldsrow0 + 32 * tt + 8 * g4 + (c >> 2)) * 144 + 8 * (c & 3);
#pragma unroll
        for (int dvt = 0; dvt < 4; ++dvt) {
            const s16x4 lo = __builtin_amdgcn_ds_read_tr16_b64_v4i16((LAS s16x4*)(vb + 32 * dvt)), hi = __builtin_amdgcn_ds_read_tr16_b64_v4i16((LAS s16x4*)(vb + 4 * 144 + 32 * dvt));
            vt[dvt] = __builtin_shufflevector(lo, hi, 0, 1, 2, 3, 4, 5, 6, 7);
        }
        attn_tile(kf, vt, qf, isel, s_lo + 32 * tt, sq, g4, o, m_run, l_run);
    }
}
constexpr int AL_V = 57600, AL_PT = 115200, AL_ML = AL_PT + 256 * 144;
__device__ __forceinline__ void attn_wg_unit(const Args& a, LAS unsigned char* lds, int b, int hd, int kb, int tid, int lane, int wave, const bf16x8 (&isel)[2]) {
    const bf16* Q = (const bf16*)(a.ws + WS_Q); const bf16* Kp = (const bf16*)(a.ws + WS_K); const bf16* Vp = (const bf16*)(a.ws + WS_V); bf16* mix = (bf16*)(a.ws + WS_MIX);
    const int c = lane & 15, g4 = lane >> 4, T0 = kb * 256; const size_t browbase = (size_t)b * SEQ;
    const int r1 = 4 * (wave >> 1) + (wave & 1), r2 = r1 + 2, tq1 = T0 + r1 + 16 * c, tq2 = T0 + r2 + 16 * c;
    LAS unsigned char* Kl = lds; LAS unsigned char* Vl = lds + AL_V;
    const size_t colb = (size_t)hd * 64;
    {
        u32x4 rk[7], rv[7];
#pragma unroll
        for (int i = 0; i < 7; ++i) { const int q = tid + 512 * i; if (q < 3200) { int tok = T0 - 128 + (q >> 3); tok = tok < 0 ? 0 : (tok > SEQ - 1 ? SEQ - 1 : tok);
            const size_t off = (browbase + tok) * AW + colb + (q & 7) * 8; rk[i] = *(const u32x4*)(Kp + off); rv[i] = *(const u32x4*)(Vp + off); } }
        __syncthreads();
#pragma unroll
        for (int i = 0; i < 7; ++i) { const int q = tid + 512 * i; if (q < 3200) { const int lo = (q >> 3) * 144 + (q & 7) * 16; *(LAS u32x4*)(Kl + lo) = rk[i]; *(LAS u32x4*)(Vl + lo) = rv[i]; } }
    }
    bf16x8 qf1[2], qf2[2];
    bf16x8 qcg[2][2];
#pragma unroll
    for (int gi = 0; gi < 2; ++gi)
#pragma unroll
        for (int ks = 0; ks < 2; ++ks) qcg[gi][ks] = *(const bf16x8*)(Q + (browbase + T0 + 16 * (wave + 8 * gi) + c) * AW + colb + 32 * ks + 8 * g4);
    f32x4 o1[4], o2[4];
#pragma unroll
    for (int i = 0; i < 4; ++i) { o1[i] = (f32x4){0.f, 0.f, 0.f, 0.f}; o2[i] = (f32x4){0.f, 0.f, 0.f, 0.f}; }
    float m1 = -INFINITY, l1 = 0.f, m2 = -INFINITY, l2 = 0.f;
    __syncthreads();
    u32x4 bk[6], bv[6];
    auto load_b = [&](int cl0) {
#pragma unroll
        for (int i = 0; i < 6; ++i) { const int q = tid + 512 * i, j = q >> 3, ci = j >= 192 ? 1 : 0, jj = j - 192 * ci; int tok = (T0 / 4 - 128 + jj) * 4 + cl0 + ci; tok = tok < 0 ? 0 : (tok > SEQ - 1 ? SEQ - 1 : tok);
            const size_t off = (browbase + tok) * AW + colb + (q & 7) * 8; bk[i] = *(const u32x4*)(Kp + off); bv[i] = *(const u32x4*)(Vp + off); }
    };
    auto store_b = [&]() {
#pragma unroll
        for (int i = 0; i < 6; ++i) { const int q = tid + 512 * i; const int lo = (q >> 3) * 144 + (q & 7) * 16; *(LAS u32x4*)(Kl + lo) = bk[i]; *(LAS u32x4*)(Vl + lo) = bv[i]; }
    };
#pragma unroll
    for (int gi = 0; gi < 2; ++gi) {
        const int gq = wave + 8 * gi, tqc = T0 + 16 * gq + c;
        if (gi == 1) {
#pragma unroll
            for (int ks = 0; ks < 2; ++ks) { qf1[ks] = *(const bf16x8*)(Q + (browbase + tq1) * AW + colb + 32 * ks + 8 * g4); qf2[ks] = *(const bf16x8*)(Q + (browbase + tq2) * AW + colb + 32 * ks + 8 * g4); }
            load_b(0);
        }
        const bf16x8 (&qc)[2] = qcg[gi];
        f32x4 oc[4];
#pragma unroll
        for (int i = 0; i < 4; ++i) oc[i] = (f32x4){0.f, 0.f, 0.f, 0.f};
        float mc = -INFINITY, lc = 0.f;
        attn_lds_pattern<5>(Kl, Vl, 16 * gq, T0 + 16 * gq - 128, tqc, c, g4, qc, isel, oc, mc, lc);
        lc = red_sum_g4(lc);
        int cx = c, gx = g4; asm volatile("" : "+v"(cx), "+v"(gx));
        LAS unsigned char* pr = lds + AL_PT + (16 * gq + cx) * 144 + 8 * gx;
#pragma unroll
        for (int dvt = 0; dvt < 4; ++dvt) { u32x2 ov; ov.x = pk(oc[dvt][0], oc[dvt][1]); ov.y = pk(oc[dvt][2], oc[dvt][3]); *(LAS u32x2*)(pr + 32 * dvt) = ov; }
        if (gx == 0) { LAS float* ml = (LAS float*)(lds + AL_ML) + 2 * (16 * gq + cx); ml[0] = mc; ml[1] = lc; }
    }
    __syncthreads(); store_b(); __syncthreads();
    {
        int cx = c, gx = g4; asm volatile("" : "+v"(cx), "+v"(gx));
        const LAS unsigned char* p1 = lds + AL_PT + (r1 + 16 * cx) * 144 + 8 * gx; const LAS unsigned char* p2 = lds + AL_PT + (r2 + 16 * cx) * 144 + 8 * gx;
#pragma unroll
        for (int dvt = 0; dvt < 4; ++dvt) { const u32x2 w1 = *(const LAS u32x2*)(p1 + 32 * dvt), w2 = *(const LAS u32x2*)(p2 + 32 * dvt);
            o1[dvt] = (f32x4){bflo(w1.x), bfhi(w1.x), bflo(w1.y), bfhi(w1.y)}; o2[dvt] = (f32x4){bflo(w2.x), bfhi(w2.x), bflo(w2.y), bfhi(w2.y)}; }
        const LAS float* ml1 = (const LAS float*)(lds + AL_ML) + 2 * (r1 + 16 * cx); const LAS float* ml2 = (const LAS float*)(lds + AL_ML) + 2 * (r2 + 16 * cx);
        m1 = ml1[0]; l1 = (gx == 0) ? ml1[1] : 0.f; m2 = ml2[0]; l2 = (gx == 0) ? ml2[1] : 0.f;
    }
    load_b(2);
    attn_lds_pattern<6>(Kl, Vl, 192 * (wave & 1), T0 / 4 - 128, T0 / 4 + (r1 >> 2) + 4 * c, c, g4, qf1, isel, o1, m1, l1);
    __syncthreads(); store_b(); __syncthreads();
    attn_lds_pattern<6>(Kl, Vl, 192 * (wave & 1), T0 / 4 - 128, T0 / 4 + (r2 >> 2) + 4 * c, c, g4, qf2, isel, o2, m2, l2);
    attn_pattern<16>(Kp, Vp, browbase, hd, T0, r1, c, g4, qf1, isel, o1, m1, l1);
    attn_pattern<16>(Kp, Vp, browbase, hd, T0, r2, c, g4, qf2, isel, o2, m2, l2);
    {
        float l = l1; l = red_sum_g4(l); const float inv = 1.f / l;
        bf16* orow = mix + (browbase + tq1) * MIXW + SW + colb + 4 * g4;
#pragma unroll
        for (int dvt = 0; dvt < 4; ++dvt) { const f32x4 w = o1[dvt] * inv; u32x2 ov; ov.x = pk(w[0], w[1]); ov.y = pk(w[2], w[3]); *(u32x2*)(orow + 16 * dvt) = ov; }
    }
    {
        float l = l2; l = red_sum_g4(l); const float inv = 1.f / l;
        bf16* orow = mix + (browbase + tq2) * MIXW + SW + colb + 4 * g4;
#pragma unroll
        for (int dvt = 0; dvt < 4; ++dvt) { const f32x4 w = o2[dvt] * inv; u32x2 ov; ov.x = pk(w[0], w[1]); ov.y = pk(w[2], w[3]); *(u32x2*)(orow + 16 * dvt) = ov; }
    }
}

constexpr int YL_ACS = 0, YL_DT = 6144, YL_B = 12288, YL_X = YL_B + 128 * 272, YL_P = YL_X + 2 * 128 * 144, YL_END = YL_P + 2 * 64 * 272;
constexpr int YL_DSK = YL_END;
static_assert(YL_DSK + 64 <= 131072, "SSD LDS map");
__device__ __forceinline__ void ssd_load_x(const bf16* xbc, size_t rowbase, int h, int tid, u32x4 (&r)[2]) {
#pragma unroll
    for (int i = 0; i < 2; ++i) { const int q = tid + 512 * i; r[i] = *(const u32x4*)(xbc + (rowbase + (q >> 3)) * CD + h * 64 + (q & 7) * 8); }
}
__device__ __forceinline__ void ssd_store_x(LAS unsigned char* X, int tid, const u32x4 (&r)[2]) {
#pragma unroll
    for (int i = 0; i < 2; ++i) { const int q = tid + 512 * i; *(LAS u32x4*)(X + (q >> 3) * 144 + (q & 7) * 16) = r[i]; }
}
__device__ __forceinline__ void ssd_load_p(const bf16* Sh, int tid, u32x4 (&r)[2]) {
#pragma unroll
    for (int i = 0; i < 2; ++i) { const int q = tid + 512 * i; r[i] = *(const u32x4*)(Sh + (q >> 4) * 128 + (q & 15) * 8); }
}
__device__ __forceinline__ void ssd_store_p(LAS unsigned char* P, int tid, const u32x4 (&r)[2]) {
#pragma unroll
    for (int i = 0; i < 2; ++i) { const int q = tid + 512 * i; *(LAS u32x4*)(P + (q >> 4) * 272 + (q & 15) * 16) = r[i]; }
}
__device__ __forceinline__ void ssd_stage_common(const Args& a, LAS unsigned char* lds, size_t rowbase, int g, int tid) {
    const bf16* xbc = (const bf16*)(a.ws + WS_XBC); const float* dt = (const float*)(a.ws + WS_DT); const float* acs = (const float*)(a.ws + WS_ACS);
    u32x4 rb[4];
#pragma unroll
    for (int i = 0; i < 4; ++i) { const int q = tid + 512 * i; rb[i] = *(const u32x4*)(xbc + (rowbase + (q >> 4)) * CD + SW + g * 128 + (q & 15) * 8); }
    LAS float* acsL = (LAS float*)(lds + YL_ACS); LAS float* dtL = (LAS float*)(lds + YL_DT);
#pragma unroll
    for (int k = 0; k < 3; ++k) { const int idx = tid + 512 * k, hh = idx >> 7, sidx = idx & 127; const size_t gi = (rowbase + sidx) * NH + 12 * g + hh; acsL[idx] = acs[gi]; dtL[idx] = dt[gi]; }
#pragma unroll
    for (int i = 0; i < 4; ++i) { const int q = tid + 512 * i; *(LAS u32x4*)(lds + YL_B + (q >> 4) * 272 + (q & 15) * 16) = rb[i]; }
    if (tid < 12) ((LAS float*)(lds + YL_DSK))[tid] = a.in[10][12 * g + tid];
}

__device__ __forceinline__ void states_unit(const Args& a, LAS unsigned char* lds, int u, int tid, int lane, int wave, const bf16x8 (&isel)[2]) {
    const bf16* xbc = (const bf16*)(a.ws + WS_XBC); bf16* S = (bf16*)a.out;
    const int g = u & 1, bc = u >> 1; const size_t rowbase = (size_t)bc * 128;
    const LAS float* acsL = (const LAS float*)(lds + YL_ACS); const LAS float* dtL = (const LAS float*)(lds + YL_DT);
    const int c = lane & 15, g4 = lane >> 4, pt = wave >> 1, nh = wave & 1;
    const f32x4 z4 = {0.f, 0.f, 0.f, 0.f};
    {
        u32x4 rx[2]; ssd_load_x(xbc, rowbase, 12 * g, tid, rx);
        ssd_stage_common(a, lds, rowbase, g, tid);
        ssd_store_x(lds + YL_X, tid, rx);
    }
    __syncthreads();
    bf16x8 iselp;
#pragma unroll
    for (int j = 0; j < 8; ++j) iselp[j] = (8 * g4 + j == 16 * (pt & 1) + c) ? (short)0x3F80 : (short)0;
    bf16x8 bmT[4][4];
#pragma unroll
    for (int kt = 0; kt < 4; ++kt)
#pragma unroll
        for (int nt = 0; nt < 4; ++nt) {
            f32x4 bm[2];
#pragma unroll
            for (int hf = 0; hf < 2; ++hf) bm[hf] = mfma16(*(const LAS bf16x8*)(lds + YL_B + (32 * kt + kkmap(c, hf)) * 272 + (64 * nh + 32 * (nt >> 1) + 8 * g4) * 2), isel[nt & 1], z4);
            bmT[kt][nt] = pack8(bm[0], bm[1]);
        }
    u32x4 rxa[2], rxb[2];
    ssd_load_x(xbc, rowbase, 12 * g + 1, tid, rxb);
    auto head = [&](int hh, u32x4 (&rx_load)[2], const u32x4 (&rx_store)[2]) {
        const int h = 12 * g + hh;
        if (hh + 2 < 12) ssd_load_x(xbc, rowbase, h + 2, tid, rx_load);
        const LAS unsigned char* X = lds + YL_X + (hh & 1) * (128 * 144);
        const float acs_last = acsL[hh * 128 + 127];
        f32x4 acc[4] = {z4, z4, z4, z4};
#pragma unroll
        for (int kt = 0; kt < 4; ++kt) {
            f32x4 t[2];
#pragma unroll
            for (int hf = 0; hf < 2; ++hf) {
                const f32x4 as4 = *(const LAS f32x4*)(acsL + hh * 128 + 32 * kt + 8 * g4 + 4 * hf), dt4 = *(const LAS f32x4*)(dtL + hh * 128 + 32 * kt + 8 * g4 + 4 * hf);
                f32x4 scl;
#pragma unroll
                for (int e = 0; e < 4; ++e) scl[e] = dt4[e] * fexp(acs_last - as4[e]);
                t[hf] = mfma16(*(const LAS bf16x8*)(X + (32 * kt + kkmap(c, hf)) * 144 + (32 * (pt >> 1) + 8 * g4) * 2), iselp, z4) * scl;
            }
            const bf16x8 xT = pack8(t[0], t[1]);
#pragma unroll
            for (int nt = 0; nt < 4; ++nt) acc[nt] = mfma16(bmT[kt][nt], xT, acc[nt]);
        }
        bf16* sp = S + ((size_t)bc * NH + h) * 8192 + (size_t)(16 * pt + c) * 128 + 64 * nh + 4 * g4;
#pragma unroll
        for (int nt = 0; nt < 4; ++nt) { u32x2 ov; ov.x = pk(acc[nt][0], acc[nt][1]); ov.y = pk(acc[nt][2], acc[nt][3]); *(u32x2*)(sp + 16 * nt) = ov; }
        if (hh + 1 < 12) ssd_store_x(lds + YL_X + ((hh + 1) & 1) * (128 * 144), tid, rx_store);
        __syncthreads();
    };
#pragma unroll 1
    for (int hh = 0; hh < 12; hh += 2) { head(hh, rxa, rxb); head(hh + 1, rxb, rxa); }
}

__device__ __forceinline__ void scan_phase(const Args& a, int tid, int G) {
    const float* acs = (const float*)(a.ws + WS_ACS); bf16* S = (bf16*)a.out;
    const int NT = G * 512;
    for (int e = blockIdx.x * 512 + tid; e < 8 * NH * 64 * 32; e += NT) {
        const int n4 = e & 31, p = (e >> 5) & 63, h = (e >> 11) % NH, b = e / (2048 * NH);
        u32x2* base = (u32x2*)(S + ((size_t)(b * 64) * NH + h) * 8192 + p * 128 + 4 * n4);
        const float* ap = acs + ((size_t)b * SEQ + 127) * NH + h;
        f32x4 carry = {0.f, 0.f, 0.f, 0.f};
        u32x2 sv[2][8]; float dc[2][8];
#pragma unroll
        for (int j = 0; j < 8; ++j) { sv[0][j] = base[(size_t)j * NH * 2048]; dc[0][j] = ap[(size_t)j * 128 * NH]; }
#pragma unroll
        for (int cb = 0; cb < 8; ++cb) {
            if (cb + 1 < 8) {
#pragma unroll
                for (int j = 0; j < 8; ++j) { sv[(cb + 1) & 1][j] = base[(size_t)((cb + 1) * 8 + j) * NH * 2048]; dc[(cb + 1) & 1][j] = ap[(size_t)((cb + 1) * 8 + j) * 128 * NH]; }
            }
#pragma unroll
            for (int j = 0; j < 8; ++j) {
                const u32x2 w = sv[cb & 1][j];
                u32x2 ov; ov.x = pk(carry[0], carry[1]); ov.y = pk(carry[2], carry[3]); base[(size_t)(cb * 8 + j) * NH * 2048] = ov;
                carry = carry * fexp(dc[cb & 1][j]) + (f32x4){bflo(w.x), bfhi(w.x), bflo(w.y), bfhi(w.y)};
            }
        }
    }
}

__device__ __forceinline__ void y_unit(const Args& a, LAS unsigned char* lds, int u, int tid, int lane, int wave, const bf16x8 (&isel)[2]) {
    const bf16* xbc = (const bf16*)(a.ws + WS_XBC); const bf16* zb = (const bf16*)(a.ws + WS_Z);
    const bf16* S = (const bf16*)a.out; bf16* mix = (bf16*)(a.ws + WS_MIX);
    const int g = u & 1, bc = u >> 1; const size_t rowbase = (size_t)bc * 128;
    const LAS float* acsL = (const LAS float*)(lds + YL_ACS); const LAS float* dtL = (const LAS float*)(lds + YL_DT);
    const int lb = (wave < 4) ? wave : 11 - wave;
    const int c = lane & 15, g4 = lane >> 4, l = 16 * lb + c, ktmax = lb >> 1; const size_t myrow = rowbase + l;
    const f32x4 z4 = {0.f, 0.f, 0.f, 0.f};
    {
        u32x4 rx[2], rp[2]; ssd_load_x(xbc, rowbase, 12 * g, tid, rx); ssd_load_p(S + ((size_t)bc * NH + 12 * g) * 8192, tid, rp);
        ssd_stage_common(a, lds, rowbase, g, tid);
        ssd_store_x(lds + YL_X, tid, rx); ssd_store_p(lds + YL_P, tid, rp);
    }
    bf16x8 cf[4];
#pragma unroll
    for (int ks = 0; ks < 4; ++ks) cf[ks] = *(const bf16x8*)(xbc + myrow * CD + SW + 256 + g * 128 + 32 * ks + 8 * g4);
    __syncthreads();
    f32x4 cbt[4][2];
#pragma unroll
    for (int kt = 0; kt < 4; ++kt)
#pragma unroll
        for (int hf = 0; hf < 2; ++hf) {
            cbt[kt][hf] = z4;
            if (kt <= ktmax) {
                const LAS unsigned char* rp = lds + YL_B + (32 * kt + kkmap(c, hf)) * 272 + 16 * g4;
#pragma unroll
                for (int ks = 0; ks < 4; ++ks) cbt[kt][hf] = mfma16(*(const LAS bf16x8*)(rp + 64 * ks), cf[ks], cbt[kt][hf]);
            }
        }
    float ssq = 0.f;
    u32x4 rxa[2], rpa[2]; u32x2 xza[4];
#pragma unroll
    for (int pt = 0; pt < 4; ++pt) { const int pcol = (12 * g) * 64 + 16 * pt + 4 * g4; xza[pt] = *(const u32x2*)(zb + myrow * SW + pcol); }
    auto head = [&](int hh) {
        const int h = 12 * g + hh; const float acs_l = acsL[hh * 128 + l];
        if (hh + 1 < 12) { ssd_load_x(xbc, rowbase, h + 1, tid, rxa); ssd_load_p(S + ((size_t)bc * NH + h + 1) * 8192, tid, rpa); }
        const LAS unsigned char* X = lds + YL_X + (hh & 1) * (128 * 144); const LAS unsigned char* P = lds + YL_P + (hh & 1) * (64 * 272);
        f32x4 yT[4] = {z4, z4, z4, z4};
#pragma unroll
        for (int kt = 0; kt < 4; ++kt) {
            if (kt <= ktmax) {
                f32x4 gt[2]; bf16x8 xf[2][2];
#pragma unroll
                for (int hf = 0; hf < 2; ++hf) {
                    const f32x4 as4 = *(const LAS f32x4*)(acsL + hh * 128 + 32 * kt + 8 * g4 + 4 * hf), dt4 = *(const LAS f32x4*)(dtL + hh * 128 + 32 * kt + 8 * g4 + 4 * hf);
#pragma unroll
                    for (int e = 0; e < 4; ++e) { const int sidx = 32 * kt + 8 * g4 + 4 * hf + e; gt[hf][e] = (sidx <= l) ? cbt[kt][hf][e] * dt4[e] * fexp(fminf(acs_l - as4[e], 0.f)) : 0.f; }
                    const LAS unsigned char* xr = X + (32 * kt + kkmap(c, hf)) * 144 + 16 * g4;
                    xf[hf][0] = *(const LAS bf16x8*)xr; xf[hf][1] = *(const LAS bf16x8*)(xr + 64);
                }
                const bf16x8 gT = pack8(gt[0], gt[1]);
#pragma unroll
                for (int pt = 0; pt < 4; ++pt) {
                    const f32x4 t0 = mfma16(xf[0][pt >> 1], isel[pt & 1], z4), t1 = mfma16(xf[1][pt >> 1], isel[pt & 1], z4);
                    yT[pt] = mfma16(pack8(t0, t1), gT, yT[pt]);
                }
            }
        }
        const float el = fexp(acs_l), dsk = ((const LAS float*)(lds + YL_DSK))[hh];
#pragma unroll
        for (int pt = 0; pt < 4; ++pt) {
            f32x4 yo = z4;
#pragma unroll
            for (int ks = 0; ks < 4; ++ks) yo = mfma16(*(const LAS bf16x8*)(P + (16 * pt + c) * 272 + 64 * ks + 16 * g4), cf[ks], yo);
            const int pcol = h * 64 + 16 * pt + 4 * g4;
            const u32x2 xw = *(const LAS u32x2*)(X + l * 144 + (16 * pt + 4 * g4) * 2), zw = xza[pt];
            const f32x4 xv = {bflo(xw.x), bfhi(xw.x), bflo(xw.y), bfhi(xw.y)}, zv = {bflo(zw.x), bfhi(zw.x), bflo(zw.y), bfhi(zw.y)};
            f32x4 uo;
#pragma unroll
            for (int e = 0; e < 4; ++e) { const float yv = yT[pt][e] + el * yo[e] + dsk * xv[e]; uo[e] = yv * zv[e] * sigm(zv[e]); ssq += uo[e] * uo[e]; }
            u32x2 ov; ov.x = pk(uo[0], uo[1]); ov.y = pk(uo[2], uo[3]);
            *(u32x2*)(mix + myrow * MIXW + pcol) = ov;
        }
        if (hh + 1 < 12) {
#pragma unroll
            for (int pt = 0; pt < 4; ++pt) { const int pcol = (h + 1) * 64 + 16 * pt + 4 * g4; xza[pt] = *(const u32x2*)(zb + myrow * SW + pcol); }
            ssd_store_x(lds + YL_X + ((hh + 1) & 1) * (128 * 144), tid, rxa); ssd_store_p(lds + YL_P + ((hh + 1) & 1) * (64 * 272), tid, rpa);
        }
        __syncthreads();
    };
#pragma unroll 1
    for (int hh = 0; hh < 12; ++hh) head(hh);
    ssq = red_sum_g4(ssq);
    const float rs = rsqrtf(ssq * (1.f / 768.f) + EPS);
    if (g4 == 0) ((float*)(a.ws + WS_RS))[2 * myrow + g] = rs;
}

#define RLX_AGENT __ATOMIC_RELAXED, __HIP_MEMORY_SCOPE_AGENT
#define XB_TMO      128
#define XB_XCNT(j)  (256  + 64 * (j))
#define XB_XSUB(j)  (1280 + 64 * (j))
#define XB_XGEN(j)  (2304 + 64 * (j))
#define XB_TOP      3328
#define XB_TOPGEN   3392
#define XCD_BAR_WORDS 3456
#define XB_SPIN_CAP (1u << 18)

__device__ __forceinline__ unsigned xb_ld(unsigned* p)              { return __hip_atomic_load(p, __ATOMIC_RELAXED, __HIP_MEMORY_SCOPE_AGENT); }
__device__ __forceinline__ unsigned xb_add(unsigned* p, unsigned v) { return __hip_atomic_fetch_add(p, v, __ATOMIC_RELAXED, __HIP_MEMORY_SCOPE_AGENT); }
__device__ __forceinline__ unsigned xb_xcc_id() { return (unsigned)__builtin_amdgcn_s_getreg((3 << 11) | 20) & 0xFu; }
#define XB_SPIN(cond, bar) do { unsigned _sp = 0; while (cond) { __builtin_amdgcn_s_sleep(1); \
    if ((++_sp & 255u) == 0u) { if (xb_ld(&(bar)[XB_TMO])) break; if (_sp > XB_SPIN_CAP) { atomicAdd(&(bar)[XB_TMO], 1u); break; } } } } while (0)

struct XcdBarrier {
    unsigned* bar; unsigned x;
    volatile LAS unsigned* st;
};

__device__ __forceinline__ XcdBarrier xcd_barrier_post(unsigned* bar, volatile LAS unsigned* st) {
    XcdBarrier b; b.bar = bar; b.x = xb_xcc_id(); b.st = st;
    if (threadIdx.x == 0) (void)xb_add(&bar[XB_XCNT(b.x)], 1u);
    return b;
}
__device__ __forceinline__ void xcd_barrier_complete(unsigned* bar, unsigned x, unsigned& nloc, unsigned& nx) {
    const unsigned G = gridDim.x * gridDim.y * gridDim.z;
    unsigned sum, cnt, mine, sp = 0u;
    for (;;) {
        sum = 0u; cnt = 0u; mine = 0u;
#pragma unroll
        for (unsigned j = 0; j < 16; ++j) { const unsigned c = xb_ld(&bar[XB_XCNT(j)]); sum += c; cnt += (c > 0u) ? 1u : 0u; mine = (j == x) ? c : mine; }
        if (sum == G) break;
        __builtin_amdgcn_s_sleep(1);
        if ((++sp & 255u) == 0u) { if (xb_ld(&bar[XB_TMO])) break; if (sp > XB_SPIN_CAP) { atomicAdd(&bar[XB_TMO], 1u); break; } }
    }
    nloc = mine > 0u ? mine : 1u; nx = cnt > 0u ? cnt : 1u;
}

__device__ __forceinline__ void xcd_barrier(const XcdBarrier& b, const bool leader) {
    asm volatile("s_waitcnt vmcnt(0)" ::: "memory");
    __syncthreads();
    if (leader) {
        unsigned* bar = b.bar;
        __builtin_amdgcn_s_waitcnt(0);
        unsigned nloc = b.st[0], nx = b.st[1];
        if (nloc == 0u) { xcd_barrier_complete(bar, b.x, nloc, nx); b.st[0] = nloc; b.st[1] = nx; }
        const unsigned old = xb_add(&bar[XB_XSUB(b.x)], 1u);
        const unsigned gen = old / nloc;
        if (old + 1u == (gen + 1u) * nloc) {
            __builtin_amdgcn_fence(__ATOMIC_RELEASE, "agent");
            asm volatile("s_waitcnt vmcnt(0)" ::: "memory");
            const unsigned og = xb_add(&bar[XB_TOP], 1u);
            const unsigned tg = og / nx;
            if (og + 1u == (tg + 1u) * nx) xb_add(&bar[XB_TOPGEN], 1u);
            else XB_SPIN(xb_ld(&bar[XB_TOPGEN]) == tg, bar);
            __builtin_amdgcn_fence(__ATOMIC_ACQUIRE, "agent");
            xb_add(&bar[XB_XGEN(b.x)], 1u);
            asm volatile("s_waitcnt vmcnt(0)" ::: "memory");
        } else {
            XB_SPIN(xb_ld(&bar[XB_XGEN(b.x)]) == gen, bar);
            __builtin_amdgcn_fence(__ATOMIC_ACQUIRE, "agent");
            asm volatile("s_waitcnt vmcnt(0)" ::: "memory");
        }
    }
    __syncthreads();
}


constexpr size_t WS_BAR = 768 * 1024;
constexpr int LDS_MISC = 155648;
constexpr int LDS_BYTES = 163840;
__global__ void __launch_bounds__(512, 2) hymba_fwd(Args a) {
    __builtin_assume(__builtin_amdgcn_workitem_id_y() == 0); __builtin_assume(__builtin_amdgcn_workitem_id_z() == 0);
    extern __shared__ __attribute__((aligned(16))) unsigned char lds_raw[];
    LAS unsigned char* lds = (LAS unsigned char*)lds_raw;
    cg::grid_group grid = cg::this_grid();
    const int wave = __builtin_amdgcn_readfirstlane((int)threadIdx.x >> 6), G = gridDim.x;
#define TID_LANE int lane; asm volatile("v_mbcnt_lo_u32_b32 %0, -1, 0\n\tv_mbcnt_hi_u32_b32 %0, -1, %0" : "=v"(lane)); const int tid = wave * 64 + lane; (void)tid;
    unsigned char* ws = a.ws;
    const int lo = a.ph_lo, hi = a.ph_hi;
#define IN(k) (lo <= (k) && (k) < hi)
#if MK_N_LAUNCHES == 1
    volatile LAS unsigned* misc = (volatile LAS unsigned*)(lds + LDS_MISC);
    if (threadIdx.x < 2) misc[threadIdx.x] = 0u;
    __syncthreads();
    XcdBarrier bar = xcd_barrier_post((unsigned*)(ws + WS_BAR), misc);
#define SEAM(k) do { if (IN(k) && IN((k) + 1)) { int l_; asm volatile("v_mbcnt_lo_u32_b32 %0, -1, 0\n\tv_mbcnt_hi_u32_b32 %0, -1, %0" : "=v"(l_)); xcd_barrier(bar, wave == 0 && l_ == 0); } } while (0)
    if (hi > NPH) grid.sync();
#else
#define SEAM(k) do { } while (0)
#endif
    if (IN(0)) { TID_LANE p0_prologue(a, lds, tid, lane, wave, G); }
#ifdef PROBE_P0
    if (IN(0)) { TID_LANE p0_prologue(a, lds, tid, lane, wave, G); }
#endif
    SEAM(0);
    if (IN(1)) {
        pg8::Gemm g{(const bf16*)a.out, (const bf16*)(ws + WS_WIN), M, NP, D}; pg8::StaticOrder S; S.init(M, NP, G, (int)blockIdx.x);
        EpiInProj E{ws, a.in[4], a.in[5], a.in[8]};
        pg8::gemm_phase<EpiInProj, pg8::StaticOrder, true, true>(lds, g, S, E, wave);
    }
    SEAM(1);
    if (IN(2)) {
        TID_LANE
        for (int u = blockIdx.x; u < 256 * 8; u += G) conv_unit(a, u >> 3, u & 7, tid);
        for (int t = blockIdx.x * 8 + wave; t < 512 * NH; t += G * 8) acs_task(a, t, lane);
        bf16x8 isel[2]; make_isel(lane, isel);
#ifdef PROBE_ATT
        for (int rep = 0; rep < 2; ++rep)
#endif
        for (int u0 = blockIdx.x; u0 < 64 * 32; u0 += G) {
            int u = u0; if ((G & 7) == 0) { const int x = u0 & 7, v = u0 >> 3; u = ((v >> 5) * 8 + x) * 32 + (v & 31); }
            const int kb = u & 31, bh = u >> 5;
            attn_wg_unit(a, lds, bh >> 3, bh & 7, kb, tid, lane, wave, isel);
        }
    }
    SEAM(2);
    if (IN(3)) { TID_LANE bf16x8 isel[2]; make_isel(lane, isel);
#if defined(PROBE_SSD) || defined(PROBE_P3)
      for (int rep = 0; rep < 2; ++rep)
#endif
      for (int u0 = blockIdx.x; u0 < 1024; u0 += G) { int u = u0; if ((G & 7) == 0) { const int x = u0 & 7, v = u0 >> 3; u = x * 128 + v; }
          states_unit(a, lds, u, tid, lane, wave, isel); } }
    SEAM(3);
    if (IN(4)) { TID_LANE scan_phase(a, tid, G); }
    SEAM(4);
    if (IN(5)) { TID_LANE bf16x8 isel[2]; make_isel(lane, isel);
#ifdef PROBE_SSD
      for (int rep = 0; rep < 2; ++rep)
#endif
      for (int u0 = blockIdx.x; u0 < 1024; u0 += G) { int u = u0; if ((G & 7) == 0) { const int x = u0 & 7, v = u0 >> 3; u = x * 128 + v; }
          y_unit(a, lds, u, tid, lane, wave, isel); } }
    SEAM(5);
    if (IN(6)) {
        pg8::Gemm g{(const bf16*)(ws + WS_MIX), (const bf16*)(ws + WS_WOUT), M, D, MIXW}; pg8::StaticOrder S; S.init(M, D, G, (int)blockIdx.x);
        EpiResNorm<true> E{a.in[0], a.out, (bf16*)(ws + WS_XB), a.in[13], (float*)(ws + WS_SSQ1), (const float*)(ws + WS_RS)};
        pg8::gemm_phase<EpiResNorm<true>, pg8::StaticOrder, true, true>(lds, g, S, E, wave);
    }
    SEAM(6);
    if (IN(7)) {
        pg8::Gemm g{(const bf16*)(ws + WS_XB), (const bf16*)(ws + WS_WGU), M, 2 * FF, D}; pg8::StaticOrder S; S.init(M, 2 * FF, G, (int)blockIdx.x);
        EpiSwiGLU E{(const float*)(ws + WS_SSQ1), (bf16*)(ws + WS_HMID)};
        pg8::gemm_phase<EpiSwiGLU, pg8::StaticOrder, true, true>(lds, g, S, E, wave);
#ifdef PROBE_G3
        pg8::gemm_phase<EpiSwiGLU, pg8::StaticOrder, true, true>(lds, g, S, E, wave);
#endif
    }
    SEAM(7);
    if (IN(8)) {
        { pg8::Gemm g{(const bf16*)(ws + WS_HMID), (const bf16*)(ws + WS_WDN), M, D, FF}; pg8::StaticOrder S; S.init(M, D, G, (int)blockIdx.x);
          EpiResNorm<false> E{a.out, a.out, (bf16*)(ws + WS_XB), a.in[17], (float*)(ws + WS_SSQ2), nullptr};
          pg8::gemm_phase<EpiResNorm<false>, pg8::StaticOrder, true, true>(lds, g, S, E, wave); }
        { pg8::Gemm g{(const bf16*)(ws + WS_PB), (const bf16*)(ws + WS_WPLE), M, D, PD}; pg8::StaticOrder S; S.init(M, D, G, (int)blockIdx.x);
          EpiPle E{(bf16*)(ws + WS_T), (float*)(ws + WS_SSQT)};
          pg8::gemm_phase<EpiPle, pg8::StaticOrder, true, true>(lds, g, S, E, wave); }
    }
    SEAM(8);
    if (IN(9)) {
        pg8::Gemm g{(const bf16*)(ws + WS_XB), (const bf16*)(ws + WS_WPG), M, D, D}; pg8::StaticOrder S; S.init(M, D, G, (int)blockIdx.x);
        EpiFinal E{a.out, (const bf16*)(ws + WS_T), (const float*)(ws + WS_SSQ2), (const float*)(ws + WS_SSQT), a.in[19], a.in[21]};
        pg8::gemm_phase<EpiFinal, pg8::StaticOrder, true, true>(lds, g, S, E, wave);
    }
#undef IN
#undef SEAM
}

#ifdef DBG_STOP
__global__ void dbg_dump(const unsigned* src, float* out, size_t n) {
    for (size_t i = (size_t)blockIdx.x * blockDim.x + threadIdx.x; i < n; i += (size_t)gridDim.x * blockDim.x) {
#ifdef DBG_ATT
        if (i < (size_t)M * 256) { const unsigned u = src[(i >> 8) * 1024 + (i & 255)]; out[i] = bflo(u) + 2.f * bfhi(u); } else out[i] = 0.f;
#else
        const unsigned u = src[i]; out[i] = bflo(u) + 2.f * bfhi(u);
#endif
    }
}
#endif
extern "C" void kernel_launch(void* const* d_in, const int* in_sizes, int n_in, void* d_out, int out_size, void* d_ws, size_t ws_size, hipStream_t stream) {
    static int grid = 0;
    if (grid == 0) {
        int dev = 0, cus = 0, per_cu = 0;
        if (n_in != 22 || ws_size < WS_END) { fprintf(stderr, "kernel_launch: unexpected n_in %d / ws %zu\n", n_in, ws_size); grid = -1; return; }
        hipGetDevice(&dev); hipDeviceGetAttribute(&cus, hipDeviceAttributeMultiprocessorCount, dev);
        if (hipFuncSetAttribute((const void*)hymba_fwd, hipFuncAttributeMaxDynamicSharedMemorySize, LDS_BYTES) != hipSuccess) { fprintf(stderr, "kernel_launch: hipFuncSetAttribute failed\n"); grid = -1; return; }
        if (hipOccupancyMaxActiveBlocksPerMultiprocessor(&per_cu, (const void*)hymba_fwd, 512, LDS_BYTES) != hipSuccess || per_cu < 1) { fprintf(stderr, "kernel_launch: occupancy query says %d\n", per_cu); per_cu = 1; }
        (void)hipGetLastError();
        grid = cus * per_cu;
    }
    if (grid < 0) return;
    if (hipMemsetAsync((char*)d_ws + WS_BAR, 0, 16384, stream) != hipSuccess) { fprintf(stderr, "kernel_launch: memset of barrier words failed\n"); return; }
    Args a{};
    for (int i = 0; i < 22; ++i) a.in[i] = (const float*)d_in[i];
    a.out = (float*)d_out; a.ws = (unsigned char*)d_ws;
#if MK_N_LAUNCHES == 1
    a.ph_lo = 0; a.ph_hi = NPH;
    void* args[] = {&a};
    hipError_t e = hipLaunchCooperativeKernel((const void*)hymba_fwd, dim3(grid), dim3(512), args, LDS_BYTES, stream);
    if (e != hipSuccess) fprintf(stderr, "cooperative launch failed: %s (grid %d)\n", hipGetErrorString(e), grid);
#else
#ifdef DBG_STOP
    for (int ph = 0; ph <= DBG_STOP; ++ph) { a.ph_lo = ph; a.ph_hi = ph + 1; hipLaunchKernelGGL(hymba_fwd, dim3(grid), dim3(512), LDS_BYTES, stream, a); }
    hipLaunchKernelGGL(dbg_dump, dim3(2048), dim3(256), 0, stream, (const unsigned*)((unsigned char*)d_ws + DBG_SRC), (float*)d_out, (size_t)M * D);
#else
    for (int ph = 0; ph < NPH; ++ph) {
        a.ph_lo = ph; a.ph_hi = ph + 1;
        hipLaunchKernelGGL(hymba_fwd, dim3(grid), dim3(512), LDS_BYTES, stream, a);
    }
#endif
#endif
}
```
